# Optimizing an MI355X kernel written in HIP

```python
import jax, jax.numpy as jnp
from jax import lax
import numpy as np

D_MODEL = 1024
BATCH = 4
SEQ = 8192
DEPTH = 4

CHUNK = 64
N_HEADS = 16
HEAD_DIM = D_MODEL // N_HEADS
D_FF = 4 * D_MODEL
N_MIXERS = 2
LEFT_CHUNKS = 8
BAND = (LEFT_CHUNKS + 1) * CHUNK
MAX_REL = 256
N_REL = 2 * MAX_REL + 1
Q_BLOCK = 128
RMS_EPS = 1e-6
N_SB_LAYERS = (DEPTH + N_MIXERS - 1) // N_MIXERS
N_CA_LAYERS = DEPTH // N_MIXERS

kernel_name = "hybrid_stickbreak_chunkrel_trunk"


def rms_norm(x, gain):
    x32 = x.astype(jnp.float32)
    y = x32 * lax.rsqrt(jnp.mean(x32 * x32, axis=-1, keepdims=True) + RMS_EPS)
    return (y * gain.astype(jnp.float32)).astype(x.dtype)


def split_heads(t):
    b, s, _ = t.shape
    return jnp.transpose(t.reshape(b, s, N_HEADS, HEAD_DIM), (0, 2, 1, 3))


def merge_heads(t):
    b, h, s, d = t.shape
    return jnp.transpose(t, (0, 2, 1, 3)).reshape(b, s, h * d)


def stick_breaking_attention(q, k, v):
    seq = q.shape[2]
    scale = HEAD_DIM ** -0.5
    outs = []
    for qb in range(seq // Q_BLOCK):
        q0 = qb * Q_BLOCK
        kl = q0 + Q_BLOCK
        qblk = q[:, :, q0:kl].astype(jnp.float32)
        kblk = k[:, :, :kl].astype(jnp.float32)
        vblk = v[:, :, :kl].astype(jnp.float32)
        z = jnp.einsum('bhqd,bhkd->bhqk', qblk, kblk) * scale
        t_pos = q0 + jnp.arange(Q_BLOCK)[:, None]
        s_pos = jnp.arange(kl)[None, :]
        valid = s_pos < t_pos
        log_1mb = jnp.where(valid, -jax.nn.softplus(z), 0.0)
        between = lax.cumsum(log_1mb, axis=3, reverse=True) - log_1mb
        log_a = jax.nn.log_sigmoid(z) + between
        a = jnp.where(valid, jnp.exp(log_a), 0.0)
        outs.append(jnp.einsum('bhqk,bhkd->bhqd', a, vblk))
    return jnp.concatenate(outs, axis=2).astype(q.dtype)


def head_rms_norm(t, gain):
    return rms_norm(t, gain)


def chunked_relpos_attention(q, k, v, rel_bias):
    b, h, seq, dh = q.shape
    n_chunks = seq // CHUNK
    pad = LEFT_CHUNKS * CHUNK
    kp = jnp.pad(k, ((0, 0), (0, 0), (pad, 0), (0, 0)))
    vp = jnp.pad(v, ((0, 0), (0, 0), (pad, 0), (0, 0)))
    qi = jnp.arange(CHUNK)[:, None]
    kj = jnp.arange(BAND)[None, :]
    rel_idx = jnp.clip(qi + pad - kj, -MAX_REL, MAX_REL) + MAX_REL
    bias = rel_bias[:, rel_idx].astype(jnp.float32)
    scale = dh ** -0.5

    def one_chunk(c):
        start = c * CHUNK
        qc = lax.dynamic_slice_in_dim(q, start, CHUNK, axis=2).astype(jnp.float32)
        kc = lax.dynamic_slice_in_dim(kp, start, BAND, axis=2).astype(jnp.float32)
        vc = lax.dynamic_slice_in_dim(vp, start, BAND, axis=2).astype(jnp.float32)
        logits = jnp.einsum('bhqd,bhkd->bhqk', qc, kc) * scale + bias[None]
        key_pos = start - pad + jnp.arange(BAND)
        logits = jnp.where((key_pos >= 0)[None, None, None, :], logits, -jnp.inf)
        p = jax.nn.softmax(logits, axis=-1)
        return jnp.einsum('bhqk,bhkd->bhqd', p, vc)

    out = lax.map(one_chunk, jnp.arange(n_chunks))
    out = jnp.transpose(out, (1, 2, 0, 3, 4)).reshape(b, h, seq, dh)
    return out.astype(q.dtype)


def setup_inputs(seed: int = 0) -> dict:
    key = jax.random.key(seed)
    ks = jax.random.split(key, 12)
    f32 = jnp.float32
    x = jax.random.normal(ks[0], (BATCH, SEQ, D_MODEL), f32)
    mix_norm = 1.0 + 0.02 * jax.random.normal(ks[1], (DEPTH, D_MODEL), f32)
    w_qkv = jax.random.normal(ks[2], (DEPTH, D_MODEL, 3 * D_MODEL), f32) * D_MODEL ** -0.5
    w_o = jax.random.normal(ks[3], (DEPTH, D_MODEL, D_MODEL), f32) * D_MODEL ** -0.5
    q_norm = 1.0 + 0.02 * jax.random.normal(ks[4], (N_CA_LAYERS, HEAD_DIM), f32)
    k_norm = 1.0 + 0.02 * jax.random.normal(ks[5], (N_CA_LAYERS, HEAD_DIM), f32)
    rel_bias = 0.1 * jax.random.normal(ks[6], (N_CA_LAYERS, N_HEADS, N_REL), f32)
    ffn_norm = 1.0 + 0.02 * jax.random.normal(ks[7], (DEPTH, D_MODEL), f32)
    w_up = jax.random.normal(ks[8], (DEPTH, D_MODEL, D_FF), f32) * D_MODEL ** -0.5
    w_down = jax.random.normal(ks[9], (DEPTH, D_FF, D_MODEL), f32) * D_FF ** -0.5
    return {"x": x, "mix_norm": mix_norm, "w_qkv": w_qkv, "w_o": w_o,
            "q_norm": q_norm, "k_norm": k_norm, "rel_bias": rel_bias,
            "ffn_norm": ffn_norm, "w_up": w_up, "w_down": w_down}


def reference(x, mix_norm, w_qkv, w_o, q_norm, k_norm, rel_bias, ffn_norm, w_up, w_down):
    for layer in range(DEPTH):
        h = rms_norm(x, mix_norm[layer])
        qkv = jnp.einsum('bsd,de->bse', h, w_qkv[layer])
        q, k, v = jnp.split(qkv, 3, axis=-1)
        q, k, v = split_heads(q), split_heads(k), split_heads(v)
        if layer % N_MIXERS == 0:
            o = stick_breaking_attention(q, k, v)
        else:
            idx = layer // N_MIXERS
            q = head_rms_norm(q, q_norm[idx])
            k = head_rms_norm(k, k_norm[idx])
            o = chunked_relpos_attention(q, k, v, rel_bias[idx])
        x = x + jnp.einsum('bsd,de->bse', merge_heads(o), w_o[layer])
        h = rms_norm(x, ffn_norm[layer])
        u = jnp.square(jax.nn.relu(jnp.einsum('bsd,df->bsf', h, w_up[layer])))
        x = x + jnp.einsum('bsf,fd->bsd', u, w_down[layer])
    return x
```

```cpp
#include <hip/hip_runtime.h>
#include <hip/hip_cooperative_groups.h>
#include <cstdio>
#include <cstdint>
namespace cg = cooperative_groups;
#define MK_ONE_LAUNCH 1
namespace pg8 {
#define PG8_LAS __attribute__((address_space(3)))
typedef unsigned short bf16_t;
typedef short bf16x8 __attribute__((ext_vector_type(8)));
typedef float f32x4 __attribute__((ext_vector_type(4)));
typedef unsigned u32x4 __attribute__((ext_vector_type(4)));
constexpr int BM = 256, BK = 64, HALF = 128, HTB = HALF * BK * 2  , STAGE_BYTES = 8 * HTB, NXCD = 8, WGM = 4;

__host__ __device__ __forceinline__ int lds_byte(int r, int c) { const int st = (r >> 4) * 2 + (c >> 5), rr = r & 15, cc = c & 31, ob = rr * 64 + cc * 2; return st * 1024 + (ob ^ (((ob >> 9) & 1) << 5)); }
__host__ __device__ __forceinline__ void stage_rc(int b, int& R, int& C) { const int st = b / 1024, sb = b % 1024, swz = sb ^ (((sb >> 9) & 1) << 5); R = (st >> 1) * 16 + swz / 64; C = (st & 1) * 32 + (swz % 64) / 2; }
__host__ __device__ __forceinline__ int perm32(int rho) { const int n = rho >> 4, i = rho & 15; return 8 * (i >> 2) + 4 * n + (i & 3); }

struct Unit { int pm, pn; };
struct Gemm { const bf16_t* A; const bf16_t* Bt; int M, N, K; };

struct StaticOrder {
    int nM, nN, nwg, G, c;
    __host__ __device__ void init(int M, int N, int G_, int c_) { nM = M / BM; nN = N / BM; nwg = nM * nN; G = G_; c = c_; }
    __host__ __device__ bool next(int i, Unit& u) const {
        const long L = (long)i * G + c; if (L >= nwg) return false;
        int wgid = (int)L; { const int q = nwg / NXCD, r = nwg % NXCD, xcd = wgid % NXCD, off = wgid / NXCD; wgid = (xcd < r ? xcd * (q + 1) : r * (q + 1) + (xcd - r) * q) + off; }
        const int nig = WGM * nN, gid = wgid / nig, fm = gid * WGM, gsz = (nM - fm) < WGM ? (nM - fm) : WGM;
        u.pm = fm + ((wgid % nig) % gsz); u.pn = (wgid % nig) / gsz; return true;
    }
    __device__ __forceinline__ void a_ready(const Unit&) const {}
    __device__ __forceinline__ void done(const Unit&) const {}
};

__device__ __forceinline__ unsigned cvt_pk_bf16(float lo, float hi) { unsigned r; asm volatile("v_cvt_pk_bf16_f32 %0, %1, %2" : "=v"(r) : "v"(lo), "v"(hi)); return r; }
typedef float f32x2 __attribute__((ext_vector_type(2)));
typedef float f32x2 __attribute__((ext_vector_type(2)));
__device__ __forceinline__ float sum_fq4(float x) {
    auto a = __builtin_amdgcn_permlane16_swap(__float_as_uint(x), __float_as_uint(x), false, false);
    const float y = __uint_as_float(a[0]) + __uint_as_float(a[1]);
    auto b = __builtin_amdgcn_permlane32_swap(__float_as_uint(y), __float_as_uint(y), false, false);
    return __uint_as_float(b[0]) + __uint_as_float(b[1]);
}
__device__ __forceinline__ float row_rinv_q(const float* ssp, int row, int fq) {
    const f32x4 a = ((const f32x4*)(ssp + (size_t)row * 16))[fq];
    float s = (a[0] + a[1]) + (a[2] + a[3]);
    s = sum_fq4(s);
    return __builtin_amdgcn_rsqf(s * (1.0f / 1024.0f) + 1e-6f);
}
__device__ __forceinline__ float row_rinv(const float* ssp, int row) {
    const f32x4* p = (const f32x4*)(ssp + (size_t)row * 16);
    const f32x4 a = p[0], b = p[1], c = p[2], d = p[3];
    const f32x4 s = (a + b) + (c + d);
    return __builtin_amdgcn_rsqf(((s[0] + s[1]) + (s[2] + s[3])) * (1.0f / 1024.0f) + 1e-6f);
}
template <int ACT> struct EpiBf16 {
    static constexpr bool PERM = true, AFTER_DRAIN = false;
    bf16_t* O; int ldc; const float* ss;
    __device__ __forceinline__ void operator()(const f32x4 (&acc)[2][2][4][2], const Unit& u, int wr, int wc, int fr, int fq) const {
        const int row0 = u.pm * BM + wr * 64 + fr, col0 = u.pn * BM + wc * 32 + 8 * fq;
        float rinv[2][4];
#pragma unroll
        for (int ai = 0; ai < 2; ++ai)
#pragma unroll
            for (int m = 0; m < 4; ++m) rinv[ai][m] = ss ? row_rinv_q(ss, row0 + ai * HALF + m * 16, fq) : 1.f;
#pragma unroll
        for (int ai = 0; ai < 2; ++ai)
#pragma unroll
            for (int m = 0; m < 4; ++m) { bf16_t* rowp = O + (size_t)(row0 + ai * HALF + m * 16) * ldc + col0;
                const float rr = rinv[ai][m];
#pragma unroll
                for (int bj = 0; bj < 2; ++bj) { f32x4 v0 = acc[ai][bj][m][0] * rr, v1 = acc[ai][bj][m][1] * rr;
                    if (ACT == 1) { const f32x4 z = (f32x4){0.f, 0.f, 0.f, 0.f}; v0 = __builtin_elementwise_max(v0, z); v1 = __builtin_elementwise_max(v1, z); v0 = v0 * v0; v1 = v1 * v1; }
                    u32x4 w; w.x = cvt_pk_bf16(v0[0], v0[1]); w.y = cvt_pk_bf16(v0[2], v0[3]); w.z = cvt_pk_bf16(v1[0], v1[1]); w.w = cvt_pk_bf16(v1[2], v1[3]);
                    *(u32x4*)(rowp + bj * HALF) = w; } }
    }
};
struct EpiQK {
    static constexpr bool PERM = true, AFTER_DRAIN = false;
    bf16_t* Q; bf16_t* K; const float* gq; const float* gk; int norm; float qscale; const float* ss;
    __device__ __forceinline__ void operator()(const f32x4 (&acc)[2][2][4][2], const Unit& u, int wr, int wc, int fr, int fq) const {
        const int t = u.pn >> 2; bf16_t* base = t ? K : Q; const float* gp = t ? gk : gq;
        const int head = ((u.pn & 3) << 2) + wc, row0 = u.pm * BM + wr * 64 + fr;
        const float sc = t ? 1.f : qscale;
        f32x4 g[2][2];
#pragma unroll
        for (int bj = 0; bj < 2; ++bj)
#pragma unroll
            for (int n = 0; n < 2; ++n) { f32x4 gv = (f32x4){1.f, 1.f, 1.f, 1.f}; if (norm) gv = *(const f32x4*)(gp + 32 * bj + 8 * fq + 4 * n); g[bj][n] = gv * sc; }
        float rinv[2][4];
#pragma unroll
        for (int ai = 0; ai < 2; ++ai)
#pragma unroll
            for (int m = 0; m < 4; ++m) rinv[ai][m] = row_rinv_q(ss, row0 + ai * HALF + m * 16, fq);
#pragma unroll
        for (int ai = 0; ai < 2; ++ai)
#pragma unroll
            for (int m = 0; m < 4; ++m) {
                const int trow = row0 + ai * HALF + m * 16;
                float r = rinv[ai][m];
                if (norm) { float s2 = 0.f;
#pragma unroll
                    for (int bj = 0; bj < 2; ++bj)
#pragma unroll
                        for (int n = 0; n < 2; ++n) { const f32x4 x = acc[ai][bj][m][n] * r; s2 += (x[0] * x[0] + x[1] * x[1]) + (x[2] * x[2] + x[3] * x[3]); }
                    s2 = sum_fq4(s2);
                    r *= __builtin_amdgcn_rsqf(s2 * (1.0f / 64.0f) + 1e-6f); }
                bf16_t* rowp = base + ((size_t)((trow >> 13) * 16 + head) * 8192 + (trow & 8191)) * 64 + 8 * fq;
#pragma unroll
                for (int bj = 0; bj < 2; ++bj) { const f32x4 v0 = acc[ai][bj][m][0] * g[bj][0] * r, v1 = acc[ai][bj][m][1] * g[bj][1] * r;
                    u32x4 w; w.x = cvt_pk_bf16(v0[0], v0[1]); w.y = cvt_pk_bf16(v0[2], v0[3]); w.z = cvt_pk_bf16(v1[0], v1[1]); w.w = cvt_pk_bf16(v1[2], v1[3]);
                    *(u32x4*)(rowp + 32 * bj) = w; } }
    }
};
struct EpiResid {
    static constexpr bool PERM = true, AFTER_DRAIN = false;
    bf16_t* xb; int ldc; const float* xin; float* fin; float* ss;
    __device__ __forceinline__ void operator()(const f32x4 (&acc)[2][2][4][2], const Unit& u, int wr, int wc, int fr, int fq) const {
        const int col0 = u.pn * BM + wc * 32 + 8 * fq;
#pragma unroll
        for (int ai = 0; ai < 2; ++ai) {
            const int rowa = u.pm * BM + ai * HALF + wr * 64 + fr;
            f32x4 pre[4][2][2];
#pragma unroll
            for (int m = 0; m < 4; ++m)
#pragma unroll
                for (int bj = 0; bj < 2; ++bj) { const size_t off = (size_t)(rowa + m * 16) * ldc + col0 + bj * HALF;
                    if (xin) { pre[m][bj][0] = *(const f32x4*)(xin + off); pre[m][bj][1] = *(const f32x4*)(xin + off + 4); }
                    else { const u32x4 w = *(const u32x4*)(xb + off);
                        pre[m][bj][0] = (f32x4){__uint_as_float(w.x << 16), __uint_as_float(w.x & 0xffff0000u), __uint_as_float(w.y << 16), __uint_as_float(w.y & 0xffff0000u)};
                        pre[m][bj][1] = (f32x4){__uint_as_float(w.z << 16), __uint_as_float(w.z & 0xffff0000u), __uint_as_float(w.w << 16), __uint_as_float(w.w & 0xffff0000u)}; } }
#pragma unroll
            for (int m = 0; m < 4; ++m) { const int row = rowa + m * 16; const size_t off = (size_t)row * ldc + col0; float s2 = 0.f;
#pragma unroll
                for (int bj = 0; bj < 2; ++bj) { const f32x4 y0 = pre[m][bj][0] + acc[ai][bj][m][0], y1 = pre[m][bj][1] + acc[ai][bj][m][1];
                    if (fin) { *(f32x4*)(fin + off + bj * HALF) = y0; *(f32x4*)(fin + off + bj * HALF + 4) = y1; }
                    else { u32x4 w; w.x = cvt_pk_bf16(y0[0], y0[1]); w.y = cvt_pk_bf16(y0[2], y0[3]); w.z = cvt_pk_bf16(y1[0], y1[1]); w.w = cvt_pk_bf16(y1[2], y1[3]); *(u32x4*)(xb + off + bj * HALF) = w; }
                    if (ss) s2 += ((y0[0] * y0[0] + y0[1] * y0[1]) + (y0[2] * y0[2] + y0[3] * y0[3])) + ((y1[0] * y1[0] + y1[1] * y1[1]) + (y1[2] * y1[2] + y1[3] * y1[3])); }
                if (ss) { s2 = sum_fq4(s2); if (fq == 0) ss[(size_t)row * 16 + u.pn * 4 + wc] = s2; } }
        }
    }
};
struct EpiVt {
    static constexpr bool PERM = true, AFTER_DRAIN = false;
    bf16_t* O; const float* ss;
    __device__ __forceinline__ void operator()(const f32x4 (&acc)[2][2][4][2], const Unit& u, int wr, int wc, int fr, int fq) const {
        typedef unsigned u32x2v __attribute__((ext_vector_type(2)));
        const int row0 = u.pm * BM + wr * 64 + fr, col0 = u.pn * BM + wc * 32 + 8 * fq;
        f32x4 rs[2][2];
#pragma unroll
        for (int bj = 0; bj < 2; ++bj)
#pragma unroll
            for (int n = 0; n < 2; ++n) rs[bj][n] = (f32x4){0.f, 0.f, 0.f, 0.f};
        {
            const float mine = row_rinv(ss, col0 + (fr >> 3) * HALF + (fr & 7));
            const int lbase = fq * 16;
#pragma unroll
            for (int bj = 0; bj < 2; ++bj)
#pragma unroll
                for (int n = 0; n < 2; ++n)
#pragma unroll
                    for (int e = 0; e < 4; ++e) rs[bj][n][e] = __shfl(mine, lbase + bj * 8 + 4 * n + e);
        }
#pragma unroll
        for (int ai = 0; ai < 2; ++ai)
#pragma unroll
            for (int m = 0; m < 4; ++m) { const int n = row0 + ai * HALF + m * 16, h = n >> 6, d = n & 63;
#pragma unroll
                for (int bj = 0; bj < 2; ++bj) { const int col = col0 + bj * HALF, b = col >> 13, t = col & 8191;
                    bf16_t* p = O + ((((size_t)(b * 16 + h) * 128 + (t >> 6)) * 64 + d) * 64) + (t & 48) + 8 * ((t >> 3) & 1);
                    const f32x4 v0 = acc[ai][bj][m][0] * rs[bj][0], v1 = acc[ai][bj][m][1] * rs[bj][1];
                    typedef float f2_t __attribute__((ext_vector_type(2))); typedef __bf16 b2_t __attribute__((ext_vector_type(2)));
                    const unsigned x0 = __builtin_bit_cast(unsigned, __builtin_convertvector((f2_t){v0[0], v0[1]}, b2_t)), x1 = __builtin_bit_cast(unsigned, __builtin_convertvector((f2_t){v0[2], v0[3]}, b2_t));
                    const unsigned y0 = __builtin_bit_cast(unsigned, __builtin_convertvector((f2_t){v1[0], v1[1]}, b2_t)), y1 = __builtin_bit_cast(unsigned, __builtin_convertvector((f2_t){v1[2], v1[3]}, b2_t));
                    auto r0 = __builtin_amdgcn_permlane16_swap(x0, y0, false, false);
                    auto r1 = __builtin_amdgcn_permlane16_swap(x1, y1, false, false);
                    u32x4 w; w.x = r0[0]; w.y = r1[0]; w.z = r0[1]; w.w = r1[1];
                    *(u32x4*)p = w; } }
    }
};
template <class Epi, class Sched, bool ALIGN_EPI = false, bool SP2 = false>
__device__ __forceinline__ void gemm_phase(PG8_LAS unsigned char* lds, const Gemm g, const Sched& S, const Epi& E) {
    int tid_ = threadIdx.x; asm volatile("" : "+v"(tid_));
    const int tid = tid_, wid = __builtin_amdgcn_readfirstlane(tid >> 6), lane = tid & 63, wr = wid >> 2, wc = wid & 3, fr = lane & 15, fq = lane >> 4;
    const int K = g.K, nt = K / BK;
    unsigned voffA[2], voffB[2];
#pragma unroll
    for (int i = 0; i < 2; ++i) { int R, C; stage_rc(tid * 16 + i * 8192, R, C); const int Rb = Epi::PERM ? ((R & ~31) + perm32(R & 31)) : R;
        voffA[i] = (unsigned)(R * K + C) * 2u; voffB[i] = (unsigned)(Rb * K + C) * 2u; }
    const size_t kstep = (size_t)(BK * 2);
    const size_t hstep = (size_t)HALF * K * 2;
    const size_t tstep = 2 * hstep;
    const unsigned ldsw = (unsigned)wid * 1024u;
    const int aoff = lds_byte(wr * 64 + fr, fq * 8), boff = lds_byte(wc * 32 + fr, fq * 8);
#define PG8_SA(b, h) (((b) * 2 + (h)) * HTB)
#define PG8_SB(b, h) ((4 + (b) * 2 + (h)) * HTB)
#define PG8_STAGE(bufoff, gbase, voff) do { _Pragma("unroll") for (int _i = 0; _i < 2; ++_i) \
        __builtin_amdgcn_global_load_lds((const unsigned*)((const char*)(gbase) + (voff)[_i]), (PG8_LAS unsigned*)(lds + (bufoff) + ldsw + _i * 8192), 16, 0, 0); } while (0)
#define PG8_LDA(dst, b, h) do { _Pragma("unroll") for (int m = 0; m < 4; ++m) _Pragma("unroll") for (int k = 0; k < 2; ++k) dst[m][k] = *(const PG8_LAS bf16x8*)(lds + PG8_SA(b, h) + aoff + m * 2048 + k * 1024); } while (0)
#define PG8_LDB(dst, b, h) do { _Pragma("unroll") for (int n = 0; n < 2; ++n) _Pragma("unroll") for (int k = 0; k < 2; ++k) dst[n][k] = *(const PG8_LAS bf16x8*)(lds + PG8_SB(b, h) + boff + n * 2048 + k * 1024); } while (0)
#define PG8_MMA(ai, bj, At, Bt) do { __builtin_amdgcn_s_setprio(1); _Pragma("unroll") for (int m = 0; m < 4; ++m) _Pragma("unroll") for (int n = 0; n < 2; ++n) _Pragma("unroll") for (int k = 0; k < 2; ++k) \
        acc[ai][bj][m][n] = __builtin_amdgcn_mfma_f32_16x16x32_bf16(Bt[n][k], At[m][k], acc[ai][bj][m][n], 0, 0, 0); __builtin_amdgcn_s_setprio(0); } while (0)
#define PG8_WAIT_V(n) asm volatile("s_waitcnt vmcnt(" #n ")" ::: "memory")
#define PG8_WAIT_L(n) asm volatile("s_waitcnt lgkmcnt(" #n ")" ::: "memory")
#define PG8_BAR __builtin_amdgcn_s_barrier()
#define PG8_SCHED __builtin_amdgcn_sched_barrier(0)
    Unit cur, nxt; int ui = 0;
    if (!S.next(0, cur)) return;
    f32x4 acc[2][2][4][2];
#pragma unroll
    for (int a = 0; a < 2; ++a)
#pragma unroll
        for (int b = 0; b < 2; ++b)
#pragma unroll
            for (int m = 0; m < 4; ++m)
#pragma unroll
                for (int n = 0; n < 2; ++n) acc[a][b][m][n] = (f32x4){0.f, 0.f, 0.f, 0.f};
    bf16x8 At[4][2], B0[2][2], B1[2][2];
    const char* cA = (const char*)g.A + (size_t)cur.pm * tstep; const char* cB = (const char*)g.Bt + (size_t)cur.pn * tstep;
    S.a_ready(cur);
    if constexpr (SP2) {
        PG8_STAGE(PG8_SB(0, 0), cB, voffB); PG8_STAGE(PG8_SB(0, 1), cB + hstep, voffB); PG8_STAGE(PG8_SA(0, 0), cA, voffA); PG8_STAGE(PG8_SA(0, 1), cA + hstep, voffA);
        if (wr == 1) PG8_BAR;
        PG8_WAIT_V(2); PG8_BAR;
        PG8_STAGE(PG8_SB(1, 0), cB + kstep, voffB); PG8_STAGE(PG8_SA(1, 0), cA + kstep, voffA); PG8_STAGE(PG8_SB(1, 1), cB + hstep + kstep, voffB);
        PG8_WAIT_V(6); PG8_BAR;
    } else {
        PG8_STAGE(PG8_SB(0, 0), cB, voffB); PG8_STAGE(PG8_SA(0, 0), cA, voffA); PG8_STAGE(PG8_SB(0, 1), cB + hstep, voffB); PG8_STAGE(PG8_SA(0, 1), cA + hstep, voffA);
        if (wr == 1) PG8_BAR;
        PG8_WAIT_V(4); PG8_BAR;
        PG8_STAGE(PG8_SB(1, 0), cB + kstep, voffB); PG8_STAGE(PG8_SA(1, 0), cA + kstep, voffA); PG8_STAGE(PG8_SB(1, 1), cB + hstep + kstep, voffB);
        PG8_WAIT_V(6); PG8_BAR;
    }
    for (;;) {
        const bool has_next = S.next(ui + 1, nxt);
        const char* nA = has_next ? (const char*)g.A + (size_t)nxt.pm * tstep : cA; const char* nB = has_next ? (const char*)g.Bt + (size_t)nxt.pn * tstep : cB;
        for (int t = 0; t < nt; t += 2) {
            const bool last = (t == nt - 2);
            const char* a1 = cA + (size_t)(t + 1) * kstep;
            const char* a2 = last ? nA : cA + (size_t)(t + 2) * kstep; const char* b2 = last ? nB : cB + (size_t)(t + 2) * kstep;
            const char* a3 = a2 + kstep; const char* b3 = b2 + kstep;
            if (last && has_next) S.a_ready(nxt);
            if constexpr (SP2) {
            PG8_LDB(B0, 0, 0); PG8_LDB(B1, 0, 1); PG8_SCHED; PG8_LDA(At, 0, 0); PG8_STAGE(PG8_SA(1, 1), a1 + hstep, voffA);
            PG8_WAIT_V(8); PG8_WAIT_L(0); PG8_BAR; PG8_MMA(0, 0, At, B0); PG8_MMA(0, 1, At, B1); PG8_BAR; PG8_SCHED;
            PG8_LDA(At, 0, 1); PG8_STAGE(PG8_SB(0, 0), b2, voffB); PG8_STAGE(PG8_SB(0, 1), b2 + hstep, voffB); PG8_STAGE(PG8_SA(0, 0), a2, voffA);
            PG8_WAIT_V(8); PG8_WAIT_L(0); PG8_BAR; PG8_MMA(1, 0, At, B0); PG8_MMA(1, 1, At, B1); PG8_BAR; PG8_SCHED;
            PG8_LDB(B0, 1, 0); PG8_LDB(B1, 1, 1); PG8_SCHED; PG8_LDA(At, 1, 0); PG8_STAGE(PG8_SA(0, 1), a2 + hstep, voffA);
            PG8_WAIT_V(8); PG8_WAIT_L(0); PG8_BAR; PG8_MMA(0, 0, At, B0); PG8_MMA(0, 1, At, B1); PG8_BAR; PG8_SCHED;
            PG8_LDA(At, 1, 1); PG8_STAGE(PG8_SB(1, 0), b3, voffB); PG8_STAGE(PG8_SB(1, 1), b3 + hstep, voffB); PG8_STAGE(PG8_SA(1, 0), a3, voffA);
            PG8_WAIT_V(8); PG8_WAIT_L(0); PG8_BAR; PG8_MMA(1, 0, At, B0); PG8_MMA(1, 1, At, B1); PG8_BAR; PG8_SCHED;
            } else {
            PG8_LDB(B0, 0, 0); PG8_SCHED; PG8_LDA(At, 0, 0); PG8_STAGE(PG8_SA(1, 1), a1 + hstep, voffA);
            PG8_WAIT_L(8); PG8_BAR; PG8_WAIT_L(0); PG8_MMA(0, 0, At, B0); PG8_BAR; PG8_SCHED;
            PG8_LDB(B1, 0, 1); PG8_STAGE(PG8_SB(0, 0), b2, voffB);
            PG8_BAR; PG8_WAIT_L(0); PG8_MMA(0, 1, At, B1); PG8_BAR;
            PG8_LDA(At, 0, 1); PG8_STAGE(PG8_SA(0, 0), a2, voffA);
            PG8_BAR; PG8_WAIT_L(0); PG8_MMA(1, 0, At, B0); PG8_BAR; PG8_SCHED;
            PG8_STAGE(PG8_SB(0, 1), b2 + hstep, voffB);
            PG8_WAIT_V(6); PG8_BAR; PG8_MMA(1, 1, At, B1); PG8_BAR;
            PG8_LDB(B0, 1, 0); PG8_SCHED; PG8_LDA(At, 1, 0); PG8_STAGE(PG8_SA(0, 1), a2 + hstep, voffA);
            PG8_WAIT_L(8); PG8_BAR; PG8_WAIT_L(0); PG8_MMA(0, 0, At, B0); PG8_BAR; PG8_SCHED;
            PG8_LDB(B1, 1, 1); PG8_STAGE(PG8_SB(1, 0), b3, voffB);
            PG8_BAR; PG8_WAIT_L(0); PG8_MMA(0, 1, At, B1); PG8_BAR;
            PG8_LDA(At, 1, 1); PG8_STAGE(PG8_SA(1, 0), a3, voffA);
            PG8_BAR; PG8_WAIT_L(0); PG8_MMA(1, 0, At, B0); PG8_BAR; PG8_SCHED;
            PG8_STAGE(PG8_SB(1, 1), b3 + hstep, voffB);
            PG8_WAIT_V(6); PG8_BAR; PG8_MMA(1, 1, At, B1); PG8_BAR;
            }
        }
        if constexpr (ALIGN_EPI) { if (wr == 0) PG8_BAR; }
        if constexpr (!Epi::AFTER_DRAIN) { E(acc, cur, wr, wc, fr, fq); S.done(cur); }
        if (!has_next) break;
#pragma unroll
        for (int a = 0; a < 2; ++a)
#pragma unroll
            for (int b = 0; b < 2; ++b)
#pragma unroll
                for (int m = 0; m < 4; ++m)
#pragma unroll
                    for (int n = 0; n < 2; ++n) acc[a][b][m][n] = (f32x4){0.f, 0.f, 0.f, 0.f};
        cur = nxt; cA = nA; cB = nB; ++ui;
        if constexpr (ALIGN_EPI) { if (wr == 1) PG8_BAR; }
    }
    PG8_WAIT_V(0);
    if constexpr (!ALIGN_EPI) { if (wr == 0) PG8_BAR; }
    PG8_BAR;
    if constexpr (Epi::AFTER_DRAIN) { E.fused(acc, cur, wr, wc, fr, fq, lds, wid, lane); S.done(cur); }
#undef PG8_SA
#undef PG8_SB
#undef PG8_STAGE
#undef PG8_LDA
#undef PG8_LDB
#undef PG8_MMA
#undef PG8_WAIT_V
#undef PG8_WAIT_L
#undef PG8_BAR
#undef PG8_SCHED
}
}

constexpr int BATCH = 4, SEQ = 8192, DM = 1024, NH = 16, HD = 64, FF = 4096, DEPTH = 4;
constexpr int MTOK = BATCH * SEQ;
constexpr int NREL = 513;
constexpr float RMS_EPS = 1e-6f;
constexpr float QSCALE = 0.125f * 1.4426950408889634f;
constexpr float LOG2E = 1.4426950408889634f;

#define LAS __attribute__((address_space(3)))
typedef unsigned short bf16;
typedef unsigned v4u __attribute__((ext_vector_type(4)));
typedef float f32x4 __attribute__((ext_vector_type(4)));

constexpr size_t MiB = 1u << 20;

constexpr size_t WS_TR = 65536;
constexpr size_t WS_BAR = 0, BAR_ZERO_BYTES = 16384;
constexpr size_t WS_W = 1 * MiB;
constexpr size_t W_LAYER = 24 * MiB, W_QK = 0, W_V = 4 * MiB, W_O = 6 * MiB, W_UP = 8 * MiB, W_DN = 16 * MiB;
constexpr size_t WS_XB = WS_W + DEPTH * W_LAYER;
constexpr size_t WS_Q = WS_XB + 64 * MiB;
constexpr size_t WS_K = WS_Q + 64 * MiB;
constexpr size_t WS_VT = WS_K + 64 * MiB;
constexpr size_t WS_O = WS_VT + 64 * MiB;
constexpr size_t WS_H = WS_Q;
constexpr size_t WS_SS = WS_H + 256 * MiB;
constexpr size_t SS_INST = (size_t)MTOK * 16;
constexpr size_t WS_END = WS_SS + 16 * MiB;

constexpr int NWAVES = 8;
constexpr int RING_BYTES = 131072;
constexpr int LDS_BYTES = 147456;
constexpr int MISC_OFF = LDS_BYTES - 64;

namespace att {
typedef short bf16x8 __attribute__((ext_vector_type(8)));
typedef short s16x4 __attribute__((ext_vector_type(4)));
typedef float f32x16 __attribute__((ext_vector_type(16)));
typedef float f32x2_t __attribute__((ext_vector_type(2)));
typedef __bf16 bf16x2_t __attribute__((ext_vector_type(2)));
typedef unsigned u32x2 __attribute__((ext_vector_type(2)));
typedef unsigned u32x4 __attribute__((ext_vector_type(4)));
#define MFMA32(a, b, c) __builtin_amdgcn_mfma_f32_32x32x16_bf16((a), (b), (c), 0, 0, 0)
__device__ __forceinline__ unsigned cvtpk(float lo, float hi) { f32x2_t v = {lo, hi}; bf16x2_t b = __builtin_convertvector(v, bf16x2_t); return __builtin_bit_cast(unsigned, b); }
__device__ __forceinline__ int crow(int r, int hi) { return (r & 3) + 8 * (r >> 2) + 4 * hi; }
__device__ __forceinline__ float partner(float v, int hi) {
    auto rr = __builtin_amdgcn_permlane32_swap(__float_as_uint(v), __float_as_uint(v), false, false);
    return __uint_as_float(hi ? rr[0] : rr[1]);
}
__device__ __forceinline__ bf16x8 pack8(const float* a) {
    u32x4 p; p.x = cvtpk(a[0], a[1]); p.y = cvtpk(a[2], a[3]); p.z = cvtpk(a[4], a[5]); p.w = cvtpk(a[6], a[7]);
    return __builtin_bit_cast(bf16x8, p);
}
struct QTile { bf16x8 q[4]; f32x16 o0, o1; float run; };
__device__ __forceinline__ void load_k(bf16x8 (&k)[4], const bf16* Kh, int k0, int r32, int hi) {
    const bf16* kp = Kh + (size_t)(k0 + r32) * 64 + 8 * hi;
#pragma unroll
    for (int d0 = 0; d0 < 4; ++d0) k[d0] = *(const bf16x8*)(kp + 16 * d0);
}
__device__ __forceinline__ void load_v(bf16x8 (&v)[4], const bf16* Vh, int k0, int r32, int hi) {
    const bf16* vp = Vh + ((size_t)(k0 >> 6) * 64 + r32) * 64 + ((k0 >> 5) & 1) * 32 + 8 * hi;
#pragma unroll
    for (int db = 0; db < 2; ++db)
#pragma unroll
        for (int s = 0; s < 2; ++s) v[db * 2 + s] = *(const bf16x8*)(vp + db * 2048 + s * 16);
}
__device__ __forceinline__ void load_q(QTile& t, const bf16* qrow, int hi) {
#pragma unroll
    for (int d0 = 0; d0 < 4; ++d0) t.q[d0] = *(const bf16x8*)(qrow + 16 * d0 + 8 * hi);
    t.o0 = f32x16{}; t.o1 = f32x16{};
}
__device__ __forceinline__ void store_o(bf16* O, size_t row, int h, int hi, const f32x16& o0, const f32x16& o1, float sc) {
    bf16* op = O + row * DM + h * 64 + 8 * hi;
#pragma unroll
    for (int half = 0; half < 2; ++half) {
        const f32x16& o = half ? o1 : o0;
#pragma unroll
        for (int g = 0; g < 4; g += 2) {
            const unsigned a0 = cvtpk(o[4 * g] * sc, o[4 * g + 1] * sc), a1 = cvtpk(o[4 * g + 2] * sc, o[4 * g + 3] * sc);
            const unsigned b0 = cvtpk(o[4 * g + 4] * sc, o[4 * g + 5] * sc), b1 = cvtpk(o[4 * g + 6] * sc, o[4 * g + 7] * sc);
            auto r0 = __builtin_amdgcn_permlane32_swap(a0, b0, false, false);
            auto r1 = __builtin_amdgcn_permlane32_swap(a1, b1, false, false);
            u32x4 w; w.x = r0[0]; w.y = r1[0]; w.z = r0[1]; w.w = r1[1];
            *(u32x4*)(op + 32 * half + 8 * g) = w;
        }
    }
}

constexpr float SB_DONE = 9.094947e-13f;
__device__ __forceinline__ void sb_tile(const bf16x8 (&fk)[4], const bf16x8 (&fv)[4], QTile& t, bool diag, int r32, int hi) {
    f32x16 st = {};
#pragma unroll
    for (int d0 = 0; d0 < 4; ++d0) { if (d0 == 0) __builtin_amdgcn_s_setprio(1); st = MFMA32(fk[d0], t.q[d0], st); }
    __builtin_amdgcn_s_setprio(0);
    float om[16];
#pragma unroll
    for (int r = 0; r < 16; ++r) {
        const float z = __builtin_amdgcn_fmed3f(st[r], -100.f, 100.f);
        const float e = __builtin_amdgcn_exp2f(-z);
        float o_ = e * __builtin_amdgcn_rcpf(1.f + e);
        if (diag) o_ = (crow(r, hi) < r32) ? o_ : 1.f;
        om[r] = o_;
    }
    float gp[4], gq[4], T[4];
#pragma unroll
    for (int g = 0; g < 4; ++g) { gp[g] = (om[4 * g] * om[4 * g + 1]) * (om[4 * g + 2] * om[4 * g + 3]); gq[g] = partner(gp[g], hi); T[g] = gp[g] * gq[g]; }
    float suf[4];
    suf[3] = t.run; suf[2] = suf[3] * T[3]; suf[1] = suf[2] * T[2]; suf[0] = suf[1] * T[1];
    t.run = suf[0] * T[0];
    float a[16];
#pragma unroll
    for (int g = 0; g < 4; ++g) {
        const float w3 = hi ? suf[g] : suf[g] * gq[g];
        const float w2 = w3 * om[4 * g + 3], w1 = w2 * om[4 * g + 2], w0 = w1 * om[4 * g + 1], wm = w0 * om[4 * g];
        a[4 * g + 3] = w3 - w2; a[4 * g + 2] = w2 - w1; a[4 * g + 1] = w1 - w0; a[4 * g] = w0 - wm;
    }
    const bf16x8 pa0 = pack8(a), pa1 = pack8(a + 8);
    __builtin_amdgcn_s_setprio(1);
    t.o0 = MFMA32(fv[0], pa0, t.o0); t.o0 = MFMA32(fv[1], pa1, t.o0);
    t.o1 = MFMA32(fv[2], pa0, t.o1); t.o1 = MFMA32(fv[3], pa1, t.o1);
    __builtin_amdgcn_s_setprio(0);
}
__device__ __forceinline__ void sb_unit(int b, int h, int t0, const bf16* Q, const bf16* K, const bf16* Vt, bf16* O, int lane) {
    const int r32 = lane & 31, hi = lane >> 5;
    const size_t bh = (size_t)b * NH + h;
    const bf16* Kh = K + bh * SEQ * 64; const bf16* Vh = Vt + bh * SEQ * 64;
    QTile A, B;
    load_q(A, Q + (bh * SEQ + t0 + r32) * 64, hi); load_q(B, Q + (bh * SEQ + t0 + 32 + r32) * 64, hi);
    A.run = 1.f; B.run = 1.f;
    bf16x8 ka[4], kb[4], vv[4];
    load_k(ka, Kh, t0 + 32, r32, hi); load_v(vv, Vh, t0 + 32, r32, hi);
    load_k(kb, Kh, t0, r32, hi);
    sb_tile(ka, vv, B, true, r32, hi);
    load_v(vv, Vh, t0, r32, hi);
    if (t0 >= 32) load_k(ka, Kh, t0 - 32, r32, hi);
    sb_tile(kb, vv, B, false, r32, hi); sb_tile(kb, vv, A, true, r32, hi);
    int k0 = t0 - 32;
    while (k0 >= 0) {
        bool dA = __all(A.run < SB_DONE), dB = __all(B.run < SB_DONE);
        if (dA && dB) break;
        load_v(vv, Vh, k0, r32, hi);
        if (k0 >= 32) load_k(kb, Kh, k0 - 32, r32, hi);
        if (!dB) sb_tile(ka, vv, B, false, r32, hi);
        if (!dA) sb_tile(ka, vv, A, false, r32, hi);
        k0 -= 32;
        if (k0 < 0) break;
        dA = __all(A.run < SB_DONE); dB = __all(B.run < SB_DONE);
        if (dA && dB) break;
        load_v(vv, Vh, k0, r32, hi);
        if (k0 >= 32) load_k(ka, Kh, k0 - 32, r32, hi);
        if (!dB) sb_tile(kb, vv, B, false, r32, hi);
        if (!dA) sb_tile(kb, vv, A, false, r32, hi);
        k0 -= 32;
    }
    store_o(O, (size_t)b * SEQ + t0 + r32, h, hi, A.o0, A.o1, 1.f);
    store_o(O, (size_t)b * SEQ + t0 + 32 + r32, h, hi, B.o0, B.o1, 1.f);
}

constexpr int NTR = 320;
__device__ __forceinline__ void ca_init(f32x16& st, int dt  , const LAS float* tr, float cfar, int r32, int hi) {
    if (dt >= 288) {
#pragma unroll
        for (int r = 0; r < 16; ++r) st[r] = cfar;
    } else {
        const int jb = 256 - dt - r32 + 4 * hi;
        if (dt <= 224) {
#pragma unroll
            for (int r = 0; r < 16; ++r) st[r] = tr[jb + (r & 3) + 8 * (r >> 2)];
        } else {
#pragma unroll
            for (int r = 0; r < 16; ++r) { int j = jb + (r & 3) + 8 * (r >> 2); j = j < 0 ? 0 : j; st[r] = tr[j]; }
        }
    }
}
__device__ __forceinline__ void ca_finish(const f32x16& st, const bf16x8 (&fv)[4], QTile& t) {
    float p[16]; float ps = 0.f;
#pragma unroll
    for (int r = 0; r < 16; ++r) { p[r] = __builtin_amdgcn_exp2f(st[r]); ps += p[r]; }
    t.run += ps;
    const bf16x8 pa0 = pack8(p), pa1 = pack8(p + 8);
    __builtin_amdgcn_s_setprio(1);
    t.o0 = MFMA32(fv[0], pa0, t.o0); t.o0 = MFMA32(fv[1], pa1, t.o0);
    t.o1 = MFMA32(fv[2], pa0, t.o1); t.o1 = MFMA32(fv[3], pa1, t.o1);
    __builtin_amdgcn_s_setprio(0);
}
__device__ __forceinline__ void ca_tile(const bf16x8 (&fk)[4], const bf16x8 (&fv)[4], QTile& t, int dt  , const LAS float* tr, float cfar, int r32, int hi) {
    f32x16 st; ca_init(st, dt, tr, cfar, r32, hi);
#pragma unroll
    for (int d0 = 0; d0 < 4; ++d0) { if (d0 == 0) __builtin_amdgcn_s_setprio(1); st = MFMA32(fk[d0], t.q[d0], st); }
    __builtin_amdgcn_s_setprio(0);
    ca_finish(st, fv, t);
}
__device__ __forceinline__ void ca_tile2(const bf16x8 (&k0)[4], const bf16x8 (&v0)[4], const bf16x8 (&k1)[4], const bf16x8 (&v1)[4], QTile& t, int dt0, const LAS float* tr, float cfar, int r32, int hi) {
    f32x16 s0, s1; ca_init(s0, dt0, tr, cfar, r32, hi); ca_init(s1, dt0 - 32, tr, cfar, r32, hi);
#pragma unroll
    for (int d0 = 0; d0 < 4; ++d0) { if (d0 == 0) __builtin_amdgcn_s_setprio(1); s0 = MFMA32(k0[d0], t.q[d0], s0); s1 = MFMA32(k1[d0], t.q[d0], s1); }
    __builtin_amdgcn_s_setprio(0);
    ca_finish(s0, v0, t); ca_finish(s1, v1, t);
}
constexpr int CA_SLOT = 8192, CA_WAVE_LDS = 2 * CA_SLOT, CA_RING_OFF = 2048;
__device__ __forceinline__ void ca_dma_tile(const bf16* Kh, const bf16* Vh, int k0, int r32, int hi, LAS unsigned char* slot) {
    const bf16* kp = Kh + (size_t)(k0 + r32) * 64 + 8 * hi;
    const bf16* vp = Vh + ((size_t)(k0 >> 6) * 64 + r32) * 64 + ((k0 >> 5) & 1) * 32 + 8 * hi;
#pragma unroll
    for (int d0 = 0; d0 < 4; ++d0) __builtin_amdgcn_global_load_lds((const unsigned*)(kp + 16 * d0), (LAS unsigned*)(slot + 1024 * d0), 16, 0, 0);
#pragma unroll
    for (int db = 0; db < 2; ++db)
#pragma unroll
        for (int sx = 0; sx < 2; ++sx) __builtin_amdgcn_global_load_lds((const unsigned*)(vp + db * 2048 + sx * 16), (LAS unsigned*)(slot + 4096 + 1024 * (db * 2 + sx)), 16, 0, 0);
}
__device__ __forceinline__ void ca_read_tile(bf16x8 (&kf)[4], bf16x8 (&vf)[4], const LAS unsigned char* slot, int lane) {
#pragma unroll
    for (int i = 0; i < 4; ++i) { kf[i] = *(const LAS bf16x8*)(slot + 1024 * i + 16 * lane); vf[i] = *(const LAS bf16x8*)(slot + 4096 + 1024 * i + 16 * lane); }
}
__device__ __forceinline__ void ca_unit(int b, int h, int t0, const bf16* Q, const bf16* K, const bf16* Vt, bf16* O, const LAS float* tr, LAS unsigned char* ring, int lane) {
    const int r32 = lane & 31, hi = lane >> 5;
    const size_t bh = (size_t)b * NH + h;
    const bf16* Kh = K + bh * SEQ * 64; const bf16* Vh = Vt + bh * SEQ * 64;
    const int c = t0 >> 6, kstart = (c >= 8) ? (c - 8) * 64 : 0, kend = t0 + 64;
    ca_dma_tile(Kh, Vh, kstart, r32, hi, ring);
    ca_dma_tile(Kh, Vh, kstart + 32, r32, hi, ring + CA_SLOT);
    QTile A, B;
    load_q(A, Q + (bh * SEQ + t0 + r32) * 64, hi); load_q(B, Q + (bh * SEQ + t0 + 32 + r32) * 64, hi);
    A.run = 0.f; B.run = 0.f;
    const float cfar = tr[0];
    bf16x8 kf[4], vf[4];
    for (int k0 = kstart; k0 < kend; k0 += 64) {
        asm volatile("s_waitcnt vmcnt(8)" ::: "memory");
        ca_read_tile(kf, vf, ring, lane);
        asm volatile("s_waitcnt lgkmcnt(0)" ::: "memory");
        if (k0 + 64 < kend) ca_dma_tile(Kh, Vh, k0 + 64, r32, hi, ring);
        ca_tile(kf, vf, A, t0 - k0, tr, cfar, r32, hi); ca_tile(kf, vf, B, t0 + 32 - k0, tr, cfar, r32, hi);
        if (k0 + 64 < kend) asm volatile("s_waitcnt vmcnt(8)" ::: "memory"); else asm volatile("s_waitcnt vmcnt(0)" ::: "memory");
        ca_read_tile(kf, vf, ring + CA_SLOT, lane);
        asm volatile("s_waitcnt lgkmcnt(0)" ::: "memory");
        if (k0 + 96 < kend) ca_dma_tile(Kh, Vh, k0 + 96, r32, hi, ring + CA_SLOT);
        ca_tile(kf, vf, A, t0 - k0 - 32, tr, cfar, r32, hi); ca_tile(kf, vf, B, t0 - k0, tr, cfar, r32, hi);
    }
    const float la = A.run + partner(A.run, hi), lb = B.run + partner(B.run, hi);
    store_o(O, (size_t)b * SEQ + t0 + r32, h, hi, A.o0, A.o1, 1.0f / la);
    store_o(O, (size_t)b * SEQ + t0 + 32 + r32, h, hi, B.o0, B.o1, 1.0f / lb);
}
constexpr int CC_STAGE = 16384, CC_RING_OFF = 2048;
__device__ __forceinline__ void cc_dma_stage(const bf16* Kh, const bf16* Vh, int j, int wave, int lane, LAS unsigned char* buf) {
    const int row = 8 * wave + (lane >> 3), c = (lane & 7) ^ ((row >> 1) & 7);
    __builtin_amdgcn_global_load_lds((const unsigned*)(Kh + (size_t)(64 * j + row) * 64 + c * 8), (LAS unsigned*)(buf + 1024 * wave), 16, 0, 0);
    __builtin_amdgcn_global_load_lds((const unsigned*)(Vh + (size_t)(64 * j + row) * 64 + c * 8), (LAS unsigned*)(buf + 8192 + 1024 * wave), 16, 0, 0);
}
__device__ __forceinline__ void cc_unit(int b, int h, int c0, const bf16* Q, const bf16* K, const bf16* Vt, bf16* O, const LAS float* tr, LAS unsigned char* ring, int wave, int lane) {
    const int r32 = lane & 31, hi = lane >> 5;
    const size_t bh = (size_t)b * NH + h;
    const bf16* Kh = K + bh * SEQ * 64; const bf16* Vh = Vt + bh * SEQ * 64;
    const int cw = c0 + (wave >> 1), t0 = 64 * cw + 32 * (wave & 1);
    const int jlo = c0 >= 8 ? c0 - 8 : 0, jhi = c0 + 3;
    QTile T; load_q(T, Q + (bh * SEQ + t0 + r32) * 64, hi); T.run = 0.f;
#pragma unroll
    for (int q = 0; q < 3; ++q) if (jlo + q <= jhi) cc_dma_stage(Kh, Vh, jlo + q, wave, lane, ring + q * CC_STAGE);
    const int key = (r32 >> 1) & 7;
    const int koff = r32 * 128, c_hi = hi;
    float cfar = 0.f;
    for (int j = jlo; j <= jhi; ++j) {
        LAS unsigned char* buf = ring + ((j - jlo) & 3) * CC_STAGE;
        if (jhi - j >= 2) asm volatile("s_waitcnt vmcnt(4) lgkmcnt(0)\n\ts_barrier" ::: "memory");
        else if (jhi - j == 1) asm volatile("s_waitcnt vmcnt(2) lgkmcnt(0)\n\ts_barrier" ::: "memory");
        else asm volatile("s_waitcnt vmcnt(0) lgkmcnt(0)\n\ts_barrier" ::: "memory");
        if (j == jlo) cfar = tr[0];
        if (j + 3 <= jhi) cc_dma_stage(Kh, Vh, j + 3, wave, lane, ring + ((j + 3 - jlo) & 3) * CC_STAGE);
        if (j >= cw - 8 && j <= cw) {
            bf16x8 kf0[4], vf0[4], kf1[4], vf1[4];
#pragma unroll
            for (int d0 = 0; d0 < 4; ++d0) { kf0[d0] = *(const LAS bf16x8*)(buf + koff + (((2 * d0 + c_hi) ^ key) * 16)); kf1[d0] = *(const LAS bf16x8*)(buf + 4096 + koff + (((2 * d0 + c_hi) ^ key) * 16)); }
#pragma unroll
            for (int db = 0; db < 2; ++db)
#pragma unroll
                for (int sx = 0; sx < 2; ++sx) { vf0[db * 2 + sx] = *(const LAS bf16x8*)(buf + 8192 + db * 4096 + koff + (((2 * sx + c_hi) ^ key) * 16));
                                                 vf1[db * 2 + sx] = *(const LAS bf16x8*)(buf + 8192 + db * 4096 + koff + (((4 + 2 * sx + c_hi) ^ key) * 16)); }
            ca_tile2(kf0, vf0, kf1, vf1, T, t0 - 64 * j, tr, cfar, r32, hi);
        }
    }
    const float l = T.run + partner(T.run, hi);
    store_o(O, (size_t)b * SEQ + t0 + r32, h, hi, T.o0, T.o1, 1.0f / l);
}
__device__ __forceinline__ float ca_head_bound(const float* gq, const float* gk, const float* rb, int lane) {
    float a = fabsf(gq[lane]), c = fabsf(gk[lane]), m = -3.0e38f;
    for (int i = lane; i < NREL; i += 64) m = fmaxf(m, rb[i]);
#pragma unroll
    for (int o = 1; o < 64; o <<= 1) { a = fmaxf(a, __shfl_xor(a, o)); c = fmaxf(c, __shfl_xor(c, o)); m = fmaxf(m, __shfl_xor(m, o)); }
    return LOG2E * (8.f * a * c + m);
}
}

#define XB_TMO      128
#define XB_XCNT(j)  (256  + 64 * (j))
#define XB_XSUB(j)  (1280 + 64 * (j))
#define XB_XGEN(j)  (2304 + 64 * (j))
#define XB_TOP      3328
#define XB_TOPGEN   3392
#define XCD_BAR_WORDS 3456
#define XB_SPIN_CAP (1u << 18)

__device__ __forceinline__ unsigned xb_ld(unsigned* p)              { return __hip_atomic_load(p, __ATOMIC_RELAXED, __HIP_MEMORY_SCOPE_AGENT); }
__device__ __forceinline__ unsigned xb_add(unsigned* p, unsigned v) { return __hip_atomic_fetch_add(p, v, __ATOMIC_RELAXED, __HIP_MEMORY_SCOPE_AGENT); }
__device__ __forceinline__ unsigned xb_xcc_id() { return (unsigned)__builtin_amdgcn_s_getreg((3 << 11) | 20) & 0xFu; }
#define XB_SPIN(cond, bar) do { unsigned _sp = 0; while (cond) { __builtin_amdgcn_s_sleep(1); \
    if ((++_sp & 255u) == 0u) { if (xb_ld(&(bar)[XB_TMO])) break; if (_sp > XB_SPIN_CAP) { atomicAdd(&(bar)[XB_TMO], 1u); break; } } } } while (0)

struct XcdBarrier {
    unsigned* bar; unsigned x;
    volatile LAS unsigned* st;
};

__device__ __forceinline__ XcdBarrier xcd_barrier_post(unsigned* bar, volatile LAS unsigned* st) {
    XcdBarrier b; b.bar = bar; b.x = xb_xcc_id(); b.st = st;
    if (threadIdx.x == 0) (void)xb_add(&bar[XB_XCNT(b.x)], 1u);
    return b;
}
__device__ __forceinline__ void xcd_barrier_complete(unsigned* bar, unsigned x, unsigned& nloc, unsigned& nx) {
    const unsigned G = gridDim.x * gridDim.y * gridDim.z;
    unsigned sum, cnt, mine, sp = 0u;
    for (;;) {
        sum = 0u; cnt = 0u; mine = 0u;
#pragma unroll
        for (unsigned j = 0; j < 16; ++j) { const unsigned c = xb_ld(&bar[XB_XCNT(j)]); sum += c; cnt += (c > 0u) ? 1u : 0u; mine = (j == x) ? c : mine; }
        if (sum == G) break;
        __builtin_amdgcn_s_sleep(1);
        if ((++sp & 255u) == 0u) { if (xb_ld(&bar[XB_TMO])) break; if (sp > XB_SPIN_CAP) { atomicAdd(&bar[XB_TMO], 1u); break; } }
    }
    nloc = mine > 0u ? mine : 1u; nx = cnt > 0u ? cnt : 1u;
}

__device__ __forceinline__ void xcd_barrier(const XcdBarrier& b) {
    asm volatile("s_waitcnt vmcnt(0)" ::: "memory");
    __syncthreads();
    if (threadIdx.x == 0) {
        unsigned* bar = b.bar;
        __builtin_amdgcn_s_waitcnt(0);
        unsigned nloc = b.st[0], nx = b.st[1];
        if (nloc == 0u) { xcd_barrier_complete(bar, b.x, nloc, nx); b.st[0] = nloc; b.st[1] = nx; }
        const unsigned old = xb_add(&bar[XB_XSUB(b.x)], 1u);
        const unsigned gen = old / nloc;
        if (old + 1u == (gen + 1u) * nloc) {
            __builtin_amdgcn_fence(__ATOMIC_RELEASE, "agent");
            asm volatile("s_waitcnt vmcnt(0)" ::: "memory");
            const unsigned og = xb_add(&bar[XB_TOP], 1u);
            const unsigned tg = og / nx;
            if (og + 1u == (tg + 1u) * nx) xb_add(&bar[XB_TOPGEN], 1u);
            else XB_SPIN(xb_ld(&bar[XB_TOPGEN]) == tg, bar);
            __builtin_amdgcn_fence(__ATOMIC_ACQUIRE, "agent");
            xb_add(&bar[XB_XGEN(b.x)], 1u);
            asm volatile("s_waitcnt vmcnt(0)" ::: "memory");
        } else {
            XB_SPIN(xb_ld(&bar[XB_XGEN(b.x)]) == gen, bar);
            __builtin_amdgcn_fence(__ATOMIC_ACQUIRE, "agent");
            asm volatile("s_waitcnt vmcnt(0)" ::: "memory");
        }
    }
    __syncthreads();
}

__device__ __forceinline__ float wave_sum(float v) {
#pragma unroll
    for (int o = 1; o < 16; o <<= 1) v += __shfl_xor(v, o);
    return pg8::sum_fq4(v);
}
__device__ __forceinline__ unsigned pk2(float lo, float hi) { return att::cvtpk(lo, hi); }

struct WItem { const float* src; const float* gain; bf16* dst; int ldn, K; };
__device__ __forceinline__ void witem_load(const WItem& w, f32x4 (&v)[8], float (&g)[8], int lane) {
    const int kq = lane >> 3, n4 = (lane & 7) * 4;
#pragma unroll
    for (int i = 0; i < 8; ++i) { v[i] = *(const f32x4*)(w.src + (size_t)(8 * i + kq) * w.ldn + n4); g[i] = w.gain ? w.gain[8 * i + kq] : 1.f; }
}
__device__ __forceinline__ void witem_finish(const WItem& w, const f32x4 (&v)[8], const float (&g)[8], LAS float* scr, int lane) {
    const int kq = lane >> 3, n4 = (lane & 7) * 4;
#pragma unroll
    for (int i = 0; i < 8; ++i) { LAS float* d = scr + (8 * i + kq) * 33 + n4; const f32x4 y = v[i] * g[i]; d[0] = y.x; d[1] = y.y; d[2] = y.z; d[3] = y.w; }
    asm volatile("s_waitcnt lgkmcnt(0)" ::: "memory");
    const int c = lane & 7;
#pragma unroll
    for (int j = 0; j < 4; ++j) { const int n = (lane >> 3) + 8 * j; const LAS float* q = scr + (8 * c) * 33 + n;
        v4u o; o.x = pk2(q[0 * 33], q[1 * 33]); o.y = pk2(q[2 * 33], q[3 * 33]); o.z = pk2(q[4 * 33], q[5 * 33]); o.w = pk2(q[6 * 33], q[7 * 33]);
        *(v4u*)(w.dst + (size_t)n * w.K + 8 * c) = o; }
    asm volatile("s_waitcnt lgkmcnt(0)" ::: "memory");
}
__device__ __forceinline__ void xrow_load(const float* xrow, f32x4 (&v)[4], int lane) {
    const f32x4* xr = (const f32x4*)xrow + 2 * lane;
#pragma unroll
    for (int j = 0; j < 4; ++j) v[j] = xr[128 * (j >> 1) + (j & 1)];
}
__device__ __forceinline__ void xrow_finish(const f32x4 (&v)[4], bf16* orow, float* ssp, int lane) {
    float s = 0.f;
#pragma unroll
    for (int j = 0; j < 4; ++j) s += (v[j].x * v[j].x + v[j].y * v[j].y) + (v[j].z * v[j].z + v[j].w * v[j].w);
    s = wave_sum(s);
    v4u* o16 = (v4u*)orow + lane;
#pragma unroll
    for (int j = 0; j < 2; ++j) { v4u w; w.x = pk2(v[2 * j].x, v[2 * j].y); w.y = pk2(v[2 * j].z, v[2 * j].w); w.z = pk2(v[2 * j + 1].x, v[2 * j + 1].y); w.w = pk2(v[2 * j + 1].z, v[2 * j + 1].w); o16[64 * j] = w; }
    if (lane < 16) ssp[lane] = lane == 0 ? s : 0.f;
}
struct Args { const float* in[10]; float* out; unsigned char* ws; int ph_lo, ph_hi; };
constexpr int PH_PER_LAYER = 5, NPH = 1 + DEPTH * PH_PER_LAYER;

__global__ void __launch_bounds__(NWAVES * 64, 2) mk_fwd(Args args) {
    extern __shared__ __attribute__((aligned(16))) unsigned char lds[];
    cg::grid_group grid = cg::this_grid();
    LAS unsigned char* ldsl = (LAS unsigned char*)lds;
    const int tid = threadIdx.x, lane = tid & 63, wave = __builtin_amdgcn_readfirstlane(tid >> 6);
    const int G = gridDim.x, bx = blockIdx.x;
    const int gw = bx * NWAVES + wave, NGW = G * NWAVES;
    unsigned char* ws = args.ws;
    const int lo = args.ph_lo, hi = args.ph_hi;
    const float* x_in = args.in[0];
    float* xres = args.out;
    float* SS = (float*)(ws + WS_SS); bf16* XB = (bf16*)(ws + WS_XB); bf16* QB = (bf16*)(ws + WS_Q); bf16* KB = (bf16*)(ws + WS_K); bf16* VT = (bf16*)(ws + WS_VT); bf16* OB = (bf16*)(ws + WS_O); bf16* HB = (bf16*)(ws + WS_H);
    volatile LAS unsigned* MISC = (volatile LAS unsigned*)(ldsl + MISC_OFF);
    if (tid < 2) MISC[tid] = 0u;
    __syncthreads();
    XcdBarrier bar = xcd_barrier_post((unsigned*)(ws + WS_BAR), MISC);
    if (lo < 0) grid.sync();
#define SEAM(ph) do { if ((ph) + 1 < hi) xcd_barrier(bar); } while (0)
#define IN(ph) (lo <= (ph) && (ph) < hi)

    if (IN(0)) {
        LAS float* scr = (LAS float*)(ldsl + wave * 16384);
        constexpr int I_QKV = 16 * 96, I_O = 16 * 32, I_UP = 16 * 128, I_DN = 64 * 32, I_LAYER = I_QKV + I_O + I_UP + I_DN, I_ALL = DEPTH * I_LAYER;
#define WITEM_DECODE(W_, it_) do { const int layer_ = (it_) / I_LAYER; int r_ = (it_) % I_LAYER; unsigned char* wl_ = ws + WS_W + (size_t)layer_ * W_LAYER; \
        if (r_ < I_QKV) { const int kb = r_ / 96, nb = r_ % 96, n0 = 32 * nb; int drow; bf16* base; \
            if (n0 < 2048) { const int blk = n0 >> 10, nn = n0 & 1023, head = nn >> 6, dh = (nn >> 5) & 1, pn = head >> 2, hl = head & 3; drow = blk * 1024 + 256 * pn + 128 * dh + 32 * hl; base = (bf16*)(wl_ + W_QK); } \
            else { drow = n0 - 2048; base = (bf16*)(wl_ + W_V); } \
            W_.src = args.in[2] + (size_t)layer_ * DM * 3 * DM + (size_t)(64 * kb) * (3 * DM) + n0; W_.gain = args.in[1] + layer_ * DM + 64 * kb; W_.dst = base + (size_t)drow * DM + 64 * kb; W_.ldn = 3 * DM; W_.K = DM; } \
        else if ((r_ -= I_QKV) < I_O) { const int kb = r_ / 32, nb = r_ % 32; \
            W_.src = args.in[3] + (size_t)layer_ * DM * DM + (size_t)(64 * kb) * DM + 32 * nb; W_.gain = nullptr; W_.dst = (bf16*)(wl_ + W_O) + (size_t)(32 * nb) * DM + 64 * kb; W_.ldn = DM; W_.K = DM; } \
        else if ((r_ -= I_O) < I_UP) { const int kb = r_ / 128, nb = r_ % 128; \
            W_.src = args.in[8] + (size_t)layer_ * DM * FF + (size_t)(64 * kb) * FF + 32 * nb; W_.gain = args.in[7] + layer_ * DM + 64 * kb; W_.dst = (bf16*)(wl_ + W_UP) + (size_t)(32 * nb) * DM + 64 * kb; W_.ldn = FF; W_.K = DM; } \
        else { r_ -= I_UP; const int kb = r_ / 32, nb = r_ % 32; \
            W_.src = args.in[9] + (size_t)layer_ * FF * DM + (size_t)(64 * kb) * DM + 32 * nb; W_.gain = nullptr; W_.dst = (bf16*)(wl_ + W_DN) + (size_t)(32 * nb) * FF + 64 * kb; W_.ldn = DM; W_.K = FF; } } while (0)
        {
            WItem wa, wb; f32x4 va[8], vb[8]; float ga[8], gb[8];
            int it = gw;
            if (it < I_ALL) { WITEM_DECODE(wa, it); witem_load(wa, va, ga, lane); }
            while (it < I_ALL) {
                const int itn = it + NGW;
                if (itn < I_ALL) { WITEM_DECODE(wb, itn); witem_load(wb, vb, gb, lane); }
                witem_finish(wa, va, ga, scr, lane);
                it = itn; wa = wb;
#pragma unroll
                for (int i = 0; i < 8; ++i) { va[i] = vb[i]; ga[i] = gb[i]; }
            }
        }
#undef WITEM_DECODE
        if (gw < 2 * NH) { const int mi = gw >> 4, hh = gw & 15; const float* rb = args.in[6] + ((size_t)mi * NH + hh) * NREL;
            const float m0 = att::ca_head_bound(args.in[4] + mi * HD, args.in[5] + mi * HD, rb, lane);
            float* trg = (float*)(ws + WS_TR) + (size_t)gw * att::NTR;
            for (int j = lane; j < att::NTR; j += 64) trg[j] = rb[512 - j] * LOG2E - m0; }
        for (int m = gw; m < MTOK; m += 4 * NGW) {
            f32x4 xv[4][4];
#pragma unroll
            for (int r = 0; r < 4; ++r) if (m + r * NGW < MTOK) xrow_load(x_in + (size_t)(m + r * NGW) * DM, xv[r], lane);
#pragma unroll
            for (int r = 0; r < 4; ++r) if (m + r * NGW < MTOK) xrow_finish(xv[r], XB + (size_t)(m + r * NGW) * DM, SS + (size_t)(m + r * NGW) * 16, lane);
        }
        SEAM(0);
    }

    for (int layer = 0; layer < DEPTH; ++layer) {
        const int p0 = 1 + layer * PH_PER_LAYER;
        if (hi <= p0 || lo >= p0 + PH_PER_LAYER) continue;
        unsigned char* wl = ws + WS_W + (size_t)layer * W_LAYER;
        const int mixer = layer & 1, midx = layer >> 1;

        if (IN(p0 + 0)) {
            {
            { pg8::Gemm g{XB, (const bf16*)(wl + W_QK), MTOK, 2 * DM, DM}; pg8::StaticOrder S; S.init(MTOK, 2 * DM, G, bx);
              pg8::EpiQK E{QB, KB, args.in[4] + midx * HD, args.in[5] + midx * HD, mixer, QSCALE, SS + (size_t)(2 * layer) * SS_INST};
              pg8::gemm_phase<pg8::EpiQK, pg8::StaticOrder, true, true>(ldsl, g, S, E); }
            { pg8::Gemm g{(const bf16*)(wl + W_V), XB, DM, MTOK, DM}; pg8::StaticOrder S; S.init(DM, MTOK, G, bx);
              pg8::EpiVt E{VT, SS + (size_t)(2 * layer) * SS_INST};
              pg8::gemm_phase<pg8::EpiVt, pg8::StaticOrder, true, true>(ldsl, g, S, E); }
            }
            SEAM(p0 + 0);
        }
        if (IN(p0 + 1)) {
            LAS float* tr = (LAS float*)ldsl;
            if (mixer == 0) {
                for (int u = bx; u < BATCH * NH * (SEQ / 512); u += G) {
                    int tid_o = threadIdx.x; asm volatile("" : "+v"(tid_o));
                    const int lane_o = tid_o & 63;
                    const int bh = u >> 4, qb = u & 15, b = bh >> 4, h = bh & 15, t0 = qb * 512 + wave * 64;
                    att::sb_unit(b, h, t0, QB, KB, VT, OB, lane_o);
                }
            } else {
                for (int u = bx; u < BATCH * NH * (SEQ / 256); u += G) {
                    int tid_o = threadIdx.x; asm volatile("" : "+v"(tid_o));
                    const int lane_o = tid_o & 63;
                    const int bh = u >> 5, qb = u & 31, b = bh >> 4, h = bh & 15;
                    const float* trg = (const float*)(ws + WS_TR) + (size_t)(midx * NH + h) * att::NTR;
                    __syncthreads();
                    if (tid_o < att::NTR) tr[tid_o] = trg[tid_o];
                    att::cc_unit(b, h, 4 * qb, QB, KB, VT, OB, tr, ldsl + att::CC_RING_OFF, wave, lane_o);
                }
            }
            __builtin_amdgcn_s_setprio(0);
            __syncthreads();
            SEAM(p0 + 1);
        }
        if (IN(p0 + 2)) {
            pg8::Gemm g{OB, (const bf16*)(wl + W_O), MTOK, DM, DM}; pg8::StaticOrder S; S.init(MTOK, DM, G, bx);
            pg8::EpiResid E{XB, DM, layer == 0 ? x_in : nullptr, nullptr, SS + (size_t)(2 * layer + 1) * SS_INST};
            pg8::gemm_phase<pg8::EpiResid, pg8::StaticOrder, true, true>(ldsl, g, S, E);
            SEAM(p0 + 2);
        }
        if (IN(p0 + 3)) {
            pg8::Gemm g{XB, (const bf16*)(wl + W_UP), MTOK, FF, DM}; pg8::StaticOrder S; S.init(MTOK, FF, G, bx);
            pg8::EpiBf16<1> E{HB, FF, SS + (size_t)(2 * layer + 1) * SS_INST};
            pg8::gemm_phase<pg8::EpiBf16<1>, pg8::StaticOrder, true, true>(ldsl, g, S, E);
            SEAM(p0 + 3);
        }
        if (IN(p0 + 4)) {
            pg8::Gemm g{HB, (const bf16*)(wl + W_DN), MTOK, DM, FF}; pg8::StaticOrder S; S.init(MTOK, DM, G, bx);
            pg8::EpiResid E{XB, DM, nullptr, layer + 1 < DEPTH ? nullptr : xres, layer + 1 < DEPTH ? SS + (size_t)(2 * layer + 2) * SS_INST : nullptr};
            pg8::gemm_phase<pg8::EpiResid, pg8::StaticOrder, true, true>(ldsl, g, S, E);
            SEAM(p0 + 4);
        }
    }
#undef SEAM
#undef IN
}

#ifndef MK_ONE_LAUNCH
#define MK_ONE_LAUNCH 0
#endif
extern "C" void kernel_launch(void* const* d_in, const int* in_sizes, int n_in, void* d_out, int out_size, void* d_ws, size_t ws_size, hipStream_t stream) {
    static int grid = 0;
    if (grid == 0) {
        if (n_in != 10 || in_sizes[0] != MTOK * DM || out_size != MTOK * DM || ws_size < WS_END) {
            fprintf(stderr, "kernel_launch: unexpected shapes / workspace (n_in %d, in0 %d, out %d, ws %zu < %zu)\n", n_in, n_in > 0 ? in_sizes[0] : -1, out_size, ws_size, (size_t)WS_END); grid = -1; return; }
        int dev = 0, cus = 0, per_cu = 0;
        (void)hipGetDevice(&dev); (void)hipDeviceGetAttribute(&cus, hipDeviceAttributeMultiprocessorCount, dev);
        if (hipFuncSetAttribute((const void*)mk_fwd, hipFuncAttributeMaxDynamicSharedMemorySize, LDS_BYTES) != hipSuccess) { fprintf(stderr, "kernel_launch: hipFuncSetAttribute failed\n"); grid = -1; return; }
        if (hipOccupancyMaxActiveBlocksPerMultiprocessor(&per_cu, (const void*)mk_fwd, NWAVES * 64, LDS_BYTES) != hipSuccess || per_cu < 1) { fprintf(stderr, "kernel_launch: occupancy query says %d blocks per CU\n", per_cu); per_cu = 1; }
        (void)hipGetLastError();
        grid = cus * per_cu;
    }
    if (grid < 0) return;
    if (hipMemsetAsync((char*)d_ws + WS_BAR, 0, BAR_ZERO_BYTES, stream) != hipSuccess) { fprintf(stderr, "kernel_launch: hipMemsetAsync failed\n"); return; }
    Args a{};
    for (int i = 0; i < 10; ++i) a.in[i] = (const float*)d_in[i];
    a.out = (float*)d_out; a.ws = (unsigned char*)d_ws;
#if MK_ONE_LAUNCH
    a.ph_lo = 0; a.ph_hi = NPH;
    void* kargs[] = {&a};
    hipError_t e = hipLaunchCooperativeKernel((const void*)mk_fwd, dim3(grid), dim3(NWAVES * 64), kargs, LDS_BYTES, stream);
    if (e != hipSuccess) fprintf(stderr, "kernel_launch: cooperative launch failed: %s (grid %d)\n", hipGetErrorString(e), grid);
#else
    for (int p = 0; p < NPH; ++p) {
        a.ph_lo = p; a.ph_hi = p + 1;
        hipLaunchKernelGGL(mk_fwd, dim3(grid), dim3(NWAVES * 64), LDS_BYTES, stream, a);
    }
#endif
}
```

```cpp
#include <hip/hip_runtime.h>
#include <hip/hip_cooperative_groups.h>
#include <cstdio>
#include <cstdint>
namespace cg = cooperative_groups;
#define MK_ONE_LAUNCH 1
namespace pg8 {
#define PG8_LAS __attribute__((address_space(3)))
typedef unsigned short bf16_t;
typedef short bf16x8 __attribute__((ext_vector_type(8)));
typedef float f32x4 __attribute__((ext_vector_type(4)));
typedef unsigned u32x4 __attribute__((ext_vector_type(4)));
constexpr int BM = 256, BK = 64, HALF = 128, HTB = HALF * BK * 2  , STAGE_BYTES = 8 * HTB, NXCD = 8, WGM = 4;

__host__ __device__ __forceinline__ int lds_byte(int r, int c) { const int st = (r >> 4) * 2 + (c >> 5), rr = r & 15, cc = c & 31, ob = rr * 64 + cc * 2; return st * 1024 + (ob ^ (((ob >> 9) & 1) << 5)); }
__host__ __device__ __forceinline__ void stage_rc(int b, int& R, int& C) { const int st = b / 1024, sb = b % 1024, swz = sb ^ (((sb >> 9) & 1) << 5); R = (st >> 1) * 16 + swz / 64; C = (st & 1) * 32 + (swz % 64) / 2; }
__host__ __device__ __forceinline__ int perm32(int rho) { const int n = rho >> 4, i = rho & 15; return 8 * (i >> 2) + 4 * n + (i & 3); }

struct Unit { int pm, pn; };
struct Gemm { const bf16_t* A; const bf16_t* Bt; int M, N, K; };

struct StaticOrder {
    int nM, nN, nwg, G, c;
    __host__ __device__ void init(int M, int N, int G_, int c_) { nM = M / BM; nN = N / BM; nwg = nM * nN; G = G_; c = c_; }
    __host__ __device__ bool next(int i, Unit& u) const {
        const long L = (long)i * G + c; if (L >= nwg) return false;
        int wgid = (int)L; { const int q = nwg / NXCD, r = nwg % NXCD, xcd = wgid % NXCD, off = wgid / NXCD; wgid = (xcd < r ? xcd * (q + 1) : r * (q + 1) + (xcd - r) * q) + off; }
        const int nig = WGM * nN, gid = wgid / nig, fm = gid * WGM, gsz = (nM - fm) < WGM ? (nM - fm) : WGM;
        u.pm = fm + ((wgid % nig) % gsz); u.pn = (wgid % nig) / gsz; return true;
    }
    __device__ __forceinline__ void a_ready(const Unit&) const {}
    __device__ __forceinline__ void done(const Unit&) const {}
};

__device__ __forceinline__ unsigned cvt_pk_bf16(float lo, float hi) { unsigned r; asm volatile("v_cvt_pk_bf16_f32 %0, %1, %2" : "=v"(r) : "v"(lo), "v"(hi)); return r; }
typedef float f32x2 __attribute__((ext_vector_type(2)));
typedef float f32x2 __attribute__((ext_vector_type(2)));
__device__ __forceinline__ float sum_fq4(float x) {
    auto a = __builtin_amdgcn_permlane16_swap(__float_as_uint(x), __float_as_uint(x), false, false);
    const float y = __uint_as_float(a[0]) + __uint_as_float(a[1]);
    auto b = __builtin_amdgcn_permlane32_swap(__float_as_uint(y), __float_as_uint(y), false, false);
    return __uint_as_float(b[0]) + __uint_as_float(b[1]);
}
__device__ __forceinline__ float row_rinv_q(const float* ssp, int row, int fq) {
    const f32x4 a = ((const f32x4*)(ssp + (size_t)row * 16))[fq];
    float s = (a[0] + a[1]) + (a[2] + a[3]);
    s = sum_fq4(s);
    return __builtin_amdgcn_rsqf(s * (1.0f / 1024.0f) + 1e-6f);
}
__device__ __forceinline__ float row_rinv(const float* ssp, int row) {
    const f32x4* p = (const f32x4*)(ssp + (size_t)row * 16);
    const f32x4 a = p[0], b = p[1], c = p[2], d = p[3];
    const f32x4 s = (a + b) + (c + d);
    return __builtin_amdgcn_rsqf(((s[0] + s[1]) + (s[2] + s[3])) * (1.0f / 1024.0f) + 1e-6f);
}
template <int ACT> struct EpiBf16 {
    static constexpr bool PERM = true, AFTER_DRAIN = false;
    bf16_t* O; int ldc; const float* ss;
    __device__ __forceinline__ void operator()(const f32x4 (&acc)[2][2][4][2], const Unit& u, int wr, int wc, int fr, int fq) const {
        const int row0 = u.pm * BM + wr * 64 + fr, col0 = u.pn * BM + wc * 32 + 8 * fq;
        float rinv[2][4];
#pragma unroll
        for (int ai = 0; ai < 2; ++ai)
#pragma unroll
            for (int m = 0; m < 4; ++m) rinv[ai][m] = ss ? row_rinv_q(ss, row0 + ai * HALF + m * 16, fq) : 1.f;
#pragma unroll
        for (int ai = 0; ai < 2; ++ai)
#pragma unroll
            for (int m = 0; m < 4; ++m) { bf16_t* rowp = O + (size_t)(row0 + ai * HALF + m * 16) * ldc + col0;
                const float rr = rinv[ai][m];
#pragma unroll
                for (int bj = 0; bj < 2; ++bj) { f32x4 v0 = acc[ai][bj][m][0] * rr, v1 = acc[ai][bj][m][1] * rr;
                    if (ACT == 1) { const f32x4 z = (f32x4){0.f, 0.f, 0.f, 0.f}; v0 = __builtin_elementwise_max(v0, z); v1 = __builtin_elementwise_max(v1, z); v0 = v0 * v0; v1 = v1 * v1; }
                    u32x4 w; w.x = cvt_pk_bf16(v0[0], v0[1]); w.y = cvt_pk_bf16(v0[2], v0[3]); w.z = cvt_pk_bf16(v1[0], v1[1]); w.w = cvt_pk_bf16(v1[2], v1[3]);
                    *(u32x4*)(rowp + bj * HALF) = w; } }
    }
};
struct EpiQK {
    static constexpr bool PERM = true, AFTER_DRAIN = false;
    bf16_t* Q; bf16_t* K; const float* gq; const float* gk; int norm; float qscale; const float* ss;
    __device__ __forceinline__ void operator()(const f32x4 (&acc)[2][2][4][2], const Unit& u, int wr, int wc, int fr, int fq) const {
        const int t = u.pn >> 2; bf16_t* base = t ? K : Q; const float* gp = t ? gk : gq;
        const int head = ((u.pn & 3) << 2) + wc, row0 = u.pm * BM + wr * 64 + fr;
        const float sc = t ? 1.f : qscale;
        f32x4 g[2][2];
#pragma unroll
        for (int bj = 0; bj < 2; ++bj)
#pragma unroll
            for (int n = 0; n < 2; ++n) { f32x4 gv = (f32x4){1.f, 1.f, 1.f, 1.f}; if (norm) gv = *(const f32x4*)(gp + 32 * bj + 8 * fq + 4 * n); g[bj][n] = gv * sc; }
        float rinv[2][4];
#pragma unroll
        for (int ai = 0; ai < 2; ++ai)
#pragma unroll
            for (int m = 0; m < 4; ++m) rinv[ai][m] = row_rinv_q(ss, row0 + ai * HALF + m * 16, fq);
#pragma unroll
        for (int ai = 0; ai < 2; ++ai)
#pragma unroll
            for (int m = 0; m < 4; ++m) {
                const int trow = row0 + ai * HALF + m * 16;
                float r = rinv[ai][m];
                if (norm) { float s2 = 0.f;
#pragma unroll
                    for (int bj = 0; bj < 2; ++bj)
#pragma unroll
                        for (int n = 0; n < 2; ++n) { const f32x4 x = acc[ai][bj][m][n] * r; s2 += (x[0] * x[0] + x[1] * x[1]) + (x[2] * x[2] + x[3] * x[3]); }
                    s2 = sum_fq4(s2);
                    r *= __builtin_amdgcn_rsqf(s2 * (1.0f / 64.0f) + 1e-6f); }
                bf16_t* rowp = base + ((size_t)((trow >> 13) * 16 + head) * 8192 + (trow & 8191)) * 64 + 8 * fq;
#pragma unroll
                for (int bj = 0; bj < 2; ++bj) { const f32x4 v0 = acc[ai][bj][m][0] * g[bj][0] * r, v1 = acc[ai][bj][m][1] * g[bj][1] * r;
                    u32x4 w; w.x = cvt_pk_bf16(v0[0], v0[1]); w.y = cvt_pk_bf16(v0[2], v0[3]); w.z = cvt_pk_bf16(v1[0], v1[1]); w.w = cvt_pk_bf16(v1[2], v1[3]);
                    *(u32x4*)(rowp + 32 * bj) = w; } }
    }
};
struct EpiResid {
    static constexpr bool PERM = true, AFTER_DRAIN = false;
    bf16_t* xb; int ldc; const float* xin; float* fin; float* ss;
    __device__ __forceinline__ void operator()(const f32x4 (&acc)[2][2][4][2], const Unit& u, int wr, int wc, int fr, int fq) const {
        const int col0 = u.pn * BM + wc * 32 + 8 * fq;
#pragma unroll
        for (int ai = 0; ai < 2; ++ai) {
            const int rowa = u.pm * BM + ai * HALF + wr * 64 + fr;
            f32x4 pre[4][2][2];
#pragma unroll
            for (int m = 0; m < 4; ++m)
#pragma unroll
                for (int bj = 0; bj < 2; ++bj) { const size_t off = (size_t)(rowa + m * 16) * ldc + col0 + bj * HALF;
                    if (xin) { pre[m][bj][0] = *(const f32x4*)(xin + off); pre[m][bj][1] = *(const f32x4*)(xin + off + 4); }
                    else { const u32x4 w = *(const u32x4*)(xb + off);
                        pre[m][bj][0] = (f32x4){__uint_as_float(w.x << 16), __uint_as_float(w.x & 0xffff0000u), __uint_as_float(w.y << 16), __uint_as_float(w.y & 0xffff0000u)};
                        pre[m][bj][1] = (f32x4){__uint_as_float(w.z << 16), __uint_as_float(w.z & 0xffff0000u), __uint_as_float(w.w << 16), __uint_as_float(w.w & 0xffff0000u)}; } }
#pragma unroll
            for (int m = 0; m < 4; ++m) { const int row = rowa + m * 16; const size_t off = (size_t)row * ldc + col0; float s2 = 0.f;
#pragma unroll
                for (int bj = 0; bj < 2; ++bj) { const f32x4 y0 = pre[m][bj][0] + acc[ai][bj][m][0], y1 = pre[m][bj][1] + acc[ai][bj][m][1];
                    if (fin) { *(f32x4*)(fin + off + bj * HALF) = y0; *(f32x4*)(fin + off + bj * HALF + 4) = y1; }
                    else { u32x4 w; w.x = cvt_pk_bf16(y0[0], y0[1]); w.y = cvt_pk_bf16(y0[2], y0[3]); w.z = cvt_pk_bf16(y1[0], y1[1]); w.w = cvt_pk_bf16(y1[2], y1[3]); *(u32x4*)(xb + off + bj * HALF) = w; }
                    if (ss) s2 += ((y0[0] * y0[0] + y0[1] * y0[1]) + (y0[2] * y0[2] + y0[3] * y0[3])) + ((y1[0] * y1[0] + y1[1] * y1[1]) + (y1[2] * y1[2] + y1[3] * y1[3])); }
                if (ss) { s2 = sum_fq4(s2); if (fq == 0) ss[(size_t)row * 16 + u.pn * 4 + wc] = s2; } }
        }
    }
};
struct EpiVt {
    static constexpr bool PERM = true, AFTER_DRAIN = false;
    bf16_t* O; const float* ss;
    __device__ __forceinline__ void operator()(const f32x4 (&acc)[2][2][4][2], const Unit& u, int wr, int wc, int fr, int fq) const {
        typedef unsigned u32x2v __attribute__((ext_vector_type(2)));
        const int row0 = u.pm * BM + wr * 64 + fr, col0 = u.pn * BM + wc * 32 + 8 * fq;
        f32x4 rs[2][2];
#pragma unroll
        for (int bj = 0; bj < 2; ++bj)
#pragma unroll
            for (int n = 0; n < 2; ++n) rs[bj][n] = (f32x4){0.f, 0.f, 0.f, 0.f};
        {
            const float mine = row_rinv(ss, col0 + (fr >> 3) * HALF + (fr & 7));
            const int lbase = fq * 16;
#pragma unroll
            for (int bj = 0; bj < 2; ++bj)
#pragma unroll
                for (int n = 0; n < 2; ++n)
#pragma unroll
                    for (int e = 0; e < 4; ++e) rs[bj][n][e] = __shfl(mine, lbase + bj * 8 + 4 * n + e);
        }
#pragma unroll
        for (int ai = 0; ai < 2; ++ai)
#pragma unroll
            for (int m = 0; m < 4; ++m) { const int n = row0 + ai * HALF + m * 16, h = n >> 6, d = n & 63;
#pragma unroll
                for (int bj = 0; bj < 2; ++bj) { const int col = col0 + bj * HALF, b = col >> 13, t = col & 8191;
                    bf16_t* p = O + ((((size_t)(b * 16 + h) * 128 + (t >> 6)) * 64 + d) * 64) + (t & 48) + 8 * ((t >> 3) & 1);
                    const f32x4 v0 = acc[ai][bj][m][0] * rs[bj][0], v1 = acc[ai][bj][m][1] * rs[bj][1];
                    typedef float f2_t __attribute__((ext_vector_type(2))); typedef __bf16 b2_t __attribute__((ext_vector_type(2)));
                    const unsigned x0 = __builtin_bit_cast(unsigned, __builtin_convertvector((f2_t){v0[0], v0[1]}, b2_t)), x1 = __builtin_bit_cast(unsigned, __builtin_convertvector((f2_t){v0[2], v0[3]}, b2_t));
                    const unsigned y0 = __builtin_bit_cast(unsigned, __builtin_convertvector((f2_t){v1[0], v1[1]}, b2_t)), y1 = __builtin_bit_cast(unsigned, __builtin_convertvector((f2_t){v1[2], v1[3]}, b2_t));
                    auto r0 = __builtin_amdgcn_permlane16_swap(x0, y0, false, false);
                    auto r1 = __builtin_amdgcn_permlane16_swap(x1, y1, false, false);
                    u32x4 w; w.x = r0[0]; w.y = r1[0]; w.z = r0[1]; w.w = r1[1];
                    *(u32x4*)p = w; } }
    }
};
template <class Epi, class Sched, bool ALIGN_EPI = false, bool SP2 = false>
__device__ __forceinline__ void gemm_phase(PG8_LAS unsigned char* lds, const Gemm g, const Sched& S, const Epi& E) {
    int tid_ = threadIdx.x; asm volatile("" : "+v"(tid_));
    const int tid = tid_, wid = __builtin_amdgcn_readfirstlane(tid >> 6), lane = tid & 63, wr = wid >> 2, wc = wid & 3, fr = lane & 15, fq = lane >> 4;
    const int K = g.K, nt = K / BK;
    unsigned voffA[2], voffB[2];
#pragma unroll
    for (int i = 0; i < 2; ++i) { int R, C; stage_rc(tid * 16 + i * 8192, R, C); const int Rb = Epi::PERM ? ((R & ~31) + perm32(R & 31)) : R;
        voffA[i] = (unsigned)(R * K + C) * 2u; voffB[i] = (unsigned)(Rb * K + C) * 2u; }
    const size_t kstep = (size_t)(BK * 2);
    const size_t hstep = (size_t)HALF * K * 2;
    const size_t tstep = 2 * hstep;
    const unsigned ldsw = (unsigned)wid * 1024u;
    const int aoff = lds_byte(wr * 64 + fr, fq * 8), boff = lds_byte(wc * 32 + fr, fq * 8);
#define PG8_SA(b, h) (((b) * 2 + (h)) * HTB)
#define PG8_SB(b, h) ((4 + (b) * 2 + (h)) * HTB)
#define PG8_STAGE(bufoff, gbase, voff) do { _Pragma("unroll") for (int _i = 0; _i < 2; ++_i) \
        __builtin_amdgcn_global_load_lds((const unsigned*)((const char*)(gbase) + (voff)[_i]), (PG8_LAS unsigned*)(lds + (bufoff) + ldsw + _i * 8192), 16, 0, 0); } while (0)
#define PG8_LDA(dst, b, h) do { _Pragma("unroll") for (int m = 0; m < 4; ++m) _Pragma("unroll") for (int k = 0; k < 2; ++k) dst[m][k] = *(const PG8_LAS bf16x8*)(lds + PG8_SA(b, h) + aoff + m * 2048 + k * 1024); } while (0)
#define PG8_LDB(dst, b, h) do { _Pragma("unroll") for (int n = 0; n < 2; ++n) _Pragma("unroll") for (int k = 0; k < 2; ++k) dst[n][k] = *(const PG8_LAS bf16x8*)(lds + PG8_SB(b, h) + boff + n * 2048 + k * 1024); } while (0)
#define PG8_MMA(ai, bj, At, Bt) do { __builtin_amdgcn_s_setprio(1); _Pragma("unroll") for (int m = 0; m < 4; ++m) _Pragma("unroll") for (int n = 0; n < 2; ++n) _Pragma("unroll") for (int k = 0; k < 2; ++k) \
        acc[ai][bj][m][n] = __builtin_amdgcn_mfma_f32_16x16x32_bf16(Bt[n][k], At[m][k], acc[ai][bj][m][n], 0, 0, 0); __builtin_amdgcn_s_setprio(0); } while (0)
#define PG8_WAIT_V(n) asm volatile("s_waitcnt vmcnt(" #n ")" ::: "memory")
#define PG8_WAIT_L(n) asm volatile("s_waitcnt lgkmcnt(" #n ")" ::: "memory")
#define PG8_BAR __builtin_amdgcn_s_barrier()
#define PG8_SCHED __builtin_amdgcn_sched_barrier(0)
    Unit cur, nxt; int ui = 0;
    if (!S.next(0, cur)) return;
    f32x4 acc[2][2][4][2];
#pragma unroll
    for (int a = 0; a < 2; ++a)
#pragma unroll
        for (int b = 0; b < 2; ++b)
#pragma unroll
            for (int m = 0; m < 4; ++m)
#pragma unroll
                for (int n = 0; n < 2; ++n) acc[a][b][m][n] = (f32x4){0.f, 0.f, 0.f, 0.f};
    bf16x8 At[4][2], B0[2][2], B1[2][2];
    const char* cA = (const char*)g.A + (size_t)cur.pm * tstep; const char* cB = (const char*)g.Bt + (size_t)cur.pn * tstep;
    S.a_ready(cur);
    if constexpr (SP2) {
        PG8_STAGE(PG8_SB(0, 0), cB, voffB); PG8_STAGE(PG8_SB(0, 1), cB + hstep, voffB); PG8_STAGE(PG8_SA(0, 0), cA, voffA); PG8_STAGE(PG8_SA(0, 1), cA + hstep, voffA);
        if (wr == 1) PG8_BAR;
        PG8_WAIT_V(2); PG8_BAR;
        PG8_STAGE(PG8_SB(1, 0), cB + kstep, voffB); PG8_STAGE(PG8_SA(1, 0), cA + kstep, voffA); PG8_STAGE(PG8_SB(1, 1), cB + hstep + kstep, voffB);
        PG8_WAIT_V(6); PG8_BAR;
    } else {
        PG8_STAGE(PG8_SB(0, 0), cB, voffB); PG8_STAGE(PG8_SA(0, 0), cA, voffA); PG8_STAGE(PG8_SB(0, 1), cB + hstep, voffB); PG8_STAGE(PG8_SA(0, 1), cA + hstep, voffA);
        if (wr == 1) PG8_BAR;
        PG8_WAIT_V(4); PG8_BAR;
        PG8_STAGE(PG8_SB(1, 0), cB + kstep, voffB); PG8_STAGE(PG8_SA(1, 0), cA + kstep, voffA); PG8_STAGE(PG8_SB(1, 1), cB + hstep + kstep, voffB);
        PG8_WAIT_V(6); PG8_BAR;
    }
    for (;;) {
        const bool has_next = S.next(ui + 1, nxt);
        const char* nA = has_next ? (const char*)g.A + (size_t)nxt.pm * tstep : cA; const char* nB = has_next ? (const char*)g.Bt + (size_t)nxt.pn * tstep : cB;
        for (int t = 0; t < nt; t += 2) {
            const bool last = (t == nt - 2);
            const char* a1 = cA + (size_t)(t + 1) * kstep;
            const char* a2 = last ? nA : cA + (size_t)(t + 2) * kstep; const char* b2 = last ? nB : cB + (size_t)(t + 2) * kstep;
            const char* a3 = a2 + kstep; const char* b3 = b2 + kstep;
            if (last && has_next) S.a_ready(nxt);
            if constexpr (SP2) {
            PG8_LDB(B0, 0, 0); PG8_LDB(B1, 0, 1); PG8_SCHED; PG8_LDA(At, 0, 0); PG8_STAGE(PG8_SA(1, 1), a1 + hstep, voffA);
            PG8_WAIT_V(8); PG8_WAIT_L(0); PG8_BAR; PG8_MMA(0, 0, At, B0); PG8_MMA(0, 1, At, B1); PG8_BAR; PG8_SCHED;
            PG8_LDA(At, 0, 1); PG8_STAGE(PG8_SB(0, 0), b2, voffB); PG8_STAGE(PG8_SB(0, 1), b2 + hstep, voffB); PG8_STAGE(PG8_SA(0, 0), a2, voffA);
            PG8_WAIT_V(8); PG8_WAIT_L(0); PG8_BAR; PG8_MMA(1, 0, At, B0); PG8_MMA(1, 1, At, B1); PG8_BAR; PG8_SCHED;
            PG8_LDB(B0, 1, 0); PG8_LDB(B1, 1, 1); PG8_SCHED; PG8_LDA(At, 1, 0); PG8_STAGE(PG8_SA(0, 1), a2 + hstep, voffA);
            PG8_WAIT_V(8); PG8_WAIT_L(0); PG8_BAR; PG8_MMA(0, 0, At, B0); PG8_MMA(0, 1, At, B1); PG8_BAR; PG8_SCHED;
            PG8_LDA(At, 1, 1); PG8_STAGE(PG8_SB(1, 0), b3, voffB); PG8_STAGE(PG8_SB(1, 1), b3 + hstep, voffB); PG8_STAGE(PG8_SA(1, 0), a3, voffA);
            PG8_WAIT_V(8); PG8_WAIT_L(0); PG8_BAR; PG8_MMA(1, 0, At, B0); PG8_MMA(1, 1, At, B1); PG8_BAR; PG8_SCHED;
            } else {
            PG8_LDB(B0, 0, 0); PG8_SCHED; PG8_LDA(At, 0, 0); PG8_STAGE(PG8_SA(1, 1), a1 + hstep, voffA);
            PG8_WAIT_L(8); PG8_BAR; PG8_WAIT_L(0); PG8_MMA(0, 0, At, B0); PG8_BAR; PG8_SCHED;
            PG8_LDB(B1, 0, 1); PG8_STAGE(PG8_SB(0, 0), b2, voffB);
            PG8_BAR; PG8_WAIT_L(0); PG8_MMA(0, 1, At, B1); PG8_BAR;
            PG8_LDA(At, 0, 1); PG8_STAGE(PG8_SA(0, 0), a2, voffA);
            PG8_BAR; PG8_WAIT_L(0); PG8_MMA(1, 0, At, B0); PG8_BAR; PG8_SCHED;
            PG8_STAGE(PG8_SB(0, 1), b2 + hstep, voffB);
            PG8_WAIT_V(6); PG8_BAR; PG8_MMA(1, 1, At, B1); PG8_BAR;
            PG8_LDB(B0, 1, 0); PG8_SCHED; PG8_LDA(At, 1, 0); PG8_STAGE(PG8_SA(0, 1), a2 + hstep, voffA);
            PG8_WAIT_L(8); PG8_BAR; PG8_WAIT_L(0); PG8_MMA(0, 0, At, B0); PG8_BAR; PG8_SCHED;
            PG8_LDB(B1, 1, 1); PG8_STAGE(PG8_SB(1, 0), b3, voffB);
            PG8_BAR; PG8_WAIT_L(0); PG8_MMA(0, 1, At, B1); PG8_BAR;
            PG8_LDA(At, 1, 1); PG8_STAGE(PG8_SA(1, 0), a3, voffA);
            PG8_BAR; PG8_WAIT_L(0); PG8_MMA(1, 0, At, B0); PG8_BAR; PG8_SCHED;
            PG8_STAGE(PG8_SB(1, 1), b3 + hstep, voffB);
            PG8_WAIT_V(6); PG8_BAR; PG8_MMA(1, 1, At, B1); PG8_BAR;
            }
        }
        if constexpr (ALIGN_EPI) { if (wr == 0) PG8_BAR; }
        if constexpr (!Epi::AFTER_DRAIN) { E(acc, cur, wr, wc, fr, fq); S.done(cur); }
        if (!has_next) break;
#pragma unroll
        for (int a = 0; a < 2; ++a)
#pragma unroll
            for (int b = 0; b < 2; ++b)
#pragma unroll
                for (int m = 0; m < 4; ++m)
#pragma unroll
                    for (int n = 0; n < 2; ++n) acc[a][b][m][n] = (f32x4){0.f, 0.f, 0.f, 0.f};
        cur = nxt; cA = nA; cB = nB; ++ui;
        if constexpr (ALIGN_EPI) { if (wr == 1) PG8_BAR; }
    }
    PG8_WAIT_V(0);
    if constexpr (!ALIGN_EPI) { if (wr == 0) PG8_BAR; }
    PG8_BAR;
    if constexpr (Epi::AFTER_DRAIN) { E.fused(acc, cur, wr, wc, fr, fq, lds, wid, lane); S.done(cur); }
#undef PG8_SA
#undef PG8_SB
#undef PG8_STAGE
#undef PG8_LDA
#undef PG8_LDB
#undef PG8_MMA
#undef PG8_WAIT_V
#undef PG8_WAIT_L
#undef PG8_BAR
#undef PG8_SCHED
}
}

constexpr int BATCH = 4, SEQ = 8192, DM = 1024, NH = 16, HD = 64, FF = 4096, DEPTH = 4;
constexpr int MTOK = BATCH * SEQ;
constexpr int NREL = 513;
constexpr float RMS_EPS = 1e-6f;
constexpr float QSCALE = 0.125f * 1.4426950408889634f;
constexpr float LOG2E = 1.4426950408889634f;

#define LAS __attribute__((address_space(3)))
typedef unsigned short bf16;
typedef unsigned v4u __attribute__((ext_vector_type(4)));
typedef float f32x4 __attribute__((ext_vector_type(4)));

constexpr size_t MiB = 1u << 20;

constexpr size_t WS_TR = 65536;
constexpr size_t WS_BAR = 0, BAR_ZERO_BYTES = 16384;
constexpr size_t WS_W = 1 * MiB;
constexpr size_t W_LAYER = 24 * MiB, W_QK = 0, W_V = 4 * MiB, W_O = 6 * MiB, W_UP = 8 * MiB, W_DN = 16 * MiB;
constexpr size_t WS_XB = WS_W + DEPTH * W_LAYER;
constexpr size_t WS_Q = WS_XB + 64 * MiB;
constexpr size_t WS_K = WS_Q + 64 * MiB;
constexpr size_t WS_VT = WS_K + 64 * MiB;
constexpr size_t WS_O = WS_VT + 64 * MiB;
constexpr size_t WS_H = WS_Q;
constexpr size_t WS_SS = WS_H + 256 * MiB;
constexpr size_t SS_INST = (size_t)MTOK * 16;
constexpr size_t WS_END = WS_SS + 16 * MiB;

constexpr int NWAVES = 8;
constexpr int RING_BYTES = 131072;
constexpr int LDS_BYTES = 147456;
constexpr int MISC_OFF = LDS_BYTES - 64;

namespace att {
typedef short bf16x8 __attribute__((ext_vector_type(8)));
typedef short s16x4 __attribute__((ext_vector_type(4)));
typedef float f32x16 __attribute__((ext_vector_type(16)));
typedef float f32x2_t __attribute__((ext_vector_type(2)));
typedef __bf16 bf16x2_t __attribute__((ext_vector_type(2)));
typedef unsigned u32x2 __attribute__((ext_vector_type(2)));
typedef unsigned u32x4 __attribute__((ext_vector_type(4)));
#define MFMA32(a, b, c) __builtin_amdgcn_mfma_f32_32x32x16_bf16((a), (b), (c), 0, 0, 0)
__device__ __forceinline__ unsigned cvtpk(float lo, float hi) { f32x2_t v = {lo, hi}; bf16x2_t b = __builtin_convertvector(v, bf16x2_t); return __builtin_bit_cast(unsigned, b); }
__device__ __forceinline__ int crow(int r, int hi) { return (r & 3) + 8 * (r >> 2) + 4 * hi; }
__device__ __forceinline__ float partner(float v, int hi) {
    auto rr = __builtin_amdgcn_permlane32_swap(__float_as_uint(v), __float_as_uint(v), false, false);
    return __uint_as_float(hi ? rr[0] : rr[1]);
}
__device__ __forceinline__ bf16x8 pack8(const float* a) {
    u32x4 p; p.x = cvtpk(a[0], a[1]); p.y = cvtpk(a[2], a[3]); p.z = cvtpk(a[4], a[5]); p.w = cvtpk(a[6], a[7]);
    return __builtin_bit_cast(bf16x8, p);
}
struct QTile { bf16x8 q[4]; f32x16 o0, o1; float run; };
__device__ __forceinline__ void load_k(bf16x8 (&k)[4], const bf16* Kh, int k0, int r32, int hi) {
    const bf16* kp = Kh + (size_t)(k0 + r32) * 64 + 8 * hi;
#pragma unroll
    for (int d0 = 0; d0 < 4; ++d0) k[d0] = *(const bf16x8*)(kp + 16 * d0);
}
__device__ __forceinline__ void load_v(bf16x8 (&v)[4], const bf16* Vh, int k0, int r32, int hi) {
    const bf16* vp = Vh + ((size_t)(k0 >> 6) * 64 + r32) * 64 + ((k0 >> 5) & 1) * 32 + 8 * hi;
#pragma unroll
    for (int db = 0; db < 2; ++db)
#pragma unroll
        for (int s = 0; s < 2; ++s) v[db * 2 + s] = *(const bf16x8*)(vp + db * 2048 + s * 16);
}
__device__ __forceinline__ void load_q(QTile& t, const bf16* qrow, int hi) {
#pragma unroll
    for (int d0 = 0; d0 < 4; ++d0) t.q[d0] = *(const bf16x8*)(qrow + 16 * d0 + 8 * hi);
    t.o0 = f32x16{}; t.o1 = f32x16{};
}
__device__ __forceinline__ void store_o(bf16* O, size_t row, int h, int hi, const f32x16& o0, const f32x16& o1, float sc) {
    bf16* op = O + row * DM + h * 64 + 8 * hi;
#pragma unroll
    for (int half = 0; half < 2; ++half) {
        const f32x16& o = half ? o1 : o0;
#pragma unroll
        for (int g = 0; g < 4; g += 2) {
            const unsigned a0 = cvtpk(o[4 * g] * sc, o[4 * g + 1] * sc), a1 = cvtpk(o[4 * g + 2] * sc, o[4 * g + 3] * sc);
            const unsigned b0 = cvtpk(o[4 * g + 4] * sc, o[4 * g + 5] * sc), b1 = cvtpk(o[4 * g + 6] * sc, o[4 * g + 7] * sc);
            auto r0 = __builtin_amdgcn_permlane32_swap(a0, b0, false, false);
            auto r1 = __builtin_amdgcn_permlane32_swap(a1, b1, false, false);
            u32x4 w; w.x = r0[0]; w.y = r1[0]; w.z = r0[1]; w.w = r1[1];
            *(u32x4*)(op + 32 * half + 8 * g) = w;
        }
    }
}

constexpr float SB_DONE = 9.094947e-13f;
__device__ __forceinline__ void sb_tile(const bf16x8 (&fk)[4], const bf16x8 (&fv)[4], QTile& t, bool diag, int r32, int hi) {
    f32x16 st = {};
#pragma unroll
    for (int d0 = 0; d0 < 4; ++d0) st = MFMA32(fk[d0], t.q[d0], st);
    float om[16];
#pragma unroll
    for (int r = 0; r < 16; ++r) {
        const float z = __builtin_amdgcn_fmed3f(st[r], -100.f, 100.f);
        const float e = __builtin_amdgcn_exp2f(-z);
        float o_ = e * __builtin_amdgcn_rcpf(1.f + e);
        if (diag) o_ = (crow(r, hi) < r32) ? o_ : 1.f;
        om[r] = o_;
    }
    float gp[4], gq[4], T[4];
#pragma unroll
    for (int g = 0; g < 4; ++g) { gp[g] = (om[4 * g] * om[4 * g + 1]) * (om[4 * g + 2] * om[4 * g + 3]); gq[g] = partner(gp[g], hi); T[g] = gp[g] * gq[g]; }
    float suf[4];
    suf[3] = t.run; suf[2] = suf[3] * T[3]; suf[1] = suf[2] * T[2]; suf[0] = suf[1] * T[1];
    t.run = suf[0] * T[0];
    float a[16];
#pragma unroll
    for (int g = 0; g < 4; ++g) {
        const float w3 = hi ? suf[g] : suf[g] * gq[g];
        const float w2 = w3 * om[4 * g + 3], w1 = w2 * om[4 * g + 2], w0 = w1 * om[4 * g + 1], wm = w0 * om[4 * g];
        a[4 * g + 3] = w3 - w2; a[4 * g + 2] = w2 - w1; a[4 * g + 1] = w1 - w0; a[4 * g] = w0 - wm;
    }
    const bf16x8 pa0 = pack8(a), pa1 = pack8(a + 8);
    t.o0 = MFMA32(fv[0], pa0, t.o0); t.o0 = MFMA32(fv[1], pa1, t.o0);
    t.o1 = MFMA32(fv[2], pa0, t.o1); t.o1 = MFMA32(fv[3], pa1, t.o1);
}
__device__ __forceinline__ void sb_unit(int b, int h, int t0, const bf16* Q, const bf16* K, const bf16* Vt, bf16* O, int lane) {
    const int r32 = lane & 31, hi = lane >> 5;
    const size_t bh = (size_t)b * NH + h;
    const bf16* Kh = K + bh * SEQ * 64; const bf16* Vh = Vt + bh * SEQ * 64;
    QTile A, B;
    load_q(A, Q + (bh * SEQ + t0 + r32) * 64, hi); load_q(B, Q + (bh * SEQ + t0 + 32 + r32) * 64, hi);
    A.run = 1.f; B.run = 1.f;
    bf16x8 ka[4], kb[4], va[4], vb[4];
    load_k(ka, Kh, t0 + 32, r32, hi); load_v(va, Vh, t0 + 32, r32, hi);
    load_k(kb, Kh, t0, r32, hi); load_v(vb, Vh, t0, r32, hi);
    sb_tile(ka, va, B, true, r32, hi);
    if (t0 >= 32) { load_k(ka, Kh, t0 - 32, r32, hi); load_v(va, Vh, t0 - 32, r32, hi); }
    sb_tile(kb, vb, B, false, r32, hi); sb_tile(kb, vb, A, true, r32, hi);
    int k0 = t0 - 32;
    while (k0 >= 0) {
        bool dA = __all(A.run < SB_DONE), dB = __all(B.run < SB_DONE);
        if (dA && dB) break;
        if (k0 >= 32) { load_k(kb, Kh, k0 - 32, r32, hi); load_v(vb, Vh, k0 - 32, r32, hi); }
        if (!dB) sb_tile(ka, va, B, false, r32, hi);
        if (!dA) sb_tile(ka, va, A, false, r32, hi);
        k0 -= 32;
        if (k0 < 0) break;
        dA = __all(A.run < SB_DONE); dB = __all(B.run < SB_DONE);
        if (dA && dB) break;
        if (k0 >= 32) { load_k(ka, Kh, k0 - 32, r32, hi); load_v(va, Vh, k0 - 32, r32, hi); }
        if (!dB) sb_tile(kb, vb, B, false, r32, hi);
        if (!dA) sb_tile(kb, vb, A, false, r32, hi);
        k0 -= 32;
    }
    store_o(O, (size_t)b * SEQ + t0 + r32, h, hi, A.o0, A.o1, 1.f);
    store_o(O, (size_t)b * SEQ + t0 + 32 + r32, h, hi, B.o0, B.o1, 1.f);
}

constexpr int NTR = 320;
__device__ __forceinline__ void ca_init(f32x16& st, int dt  , const LAS float* tr, float cfar, int r32, int hi) {
    if (dt >= 288) {
#pragma unroll
        for (int r = 0; r < 16; ++r) st[r] = cfar;
    } else {
        const int jb = 256 - dt - r32 + 4 * hi;
        if (dt <= 224) {
#pragma unroll
            for (int r = 0; r < 16; ++r) st[r] = tr[jb + (r & 3) + 8 * (r >> 2)];
        } else {
#pragma unroll
            for (int r = 0; r < 16; ++r) { int j = jb + (r & 3) + 8 * (r >> 2); j = j < 0 ? 0 : j; st[r] = tr[j]; }
        }
    }
}
__device__ __forceinline__ void ca_finish(const f32x16& st, const bf16x8 (&fv)[4], QTile& t) {
    float p[16]; float ps = 0.f;
#pragma unroll
    for (int r = 0; r < 16; ++r) { p[r] = __builtin_amdgcn_exp2f(st[r]); ps += p[r]; }
    t.run += ps;
    const bf16x8 pa0 = pack8(p), pa1 = pack8(p + 8);
    t.o0 = MFMA32(fv[0], pa0, t.o0); t.o0 = MFMA32(fv[1], pa1, t.o0);
    t.o1 = MFMA32(fv[2], pa0, t.o1); t.o1 = MFMA32(fv[3], pa1, t.o1);
}
__device__ __forceinline__ void ca_tile(const bf16x8 (&fk)[4], const bf16x8 (&fv)[4], QTile& t, int dt  , const LAS float* tr, float cfar, int r32, int hi) {
    f32x16 st; ca_init(st, dt, tr, cfar, r32, hi);
#pragma unroll
    for (int d0 = 0; d0 < 4; ++d0) st = MFMA32(fk[d0], t.q[d0], st);
    ca_finish(st, fv, t);
}
__device__ __forceinline__ void ca_tile2(const bf16x8 (&k0)[4], const bf16x8 (&v0)[4], const bf16x8 (&k1)[4], const bf16x8 (&v1)[4], QTile& t, int dt0, const LAS float* tr, float cfar, int r32, int hi) {
    f32x16 s0, s1; ca_init(s0, dt0, tr, cfar, r32, hi); ca_init(s1, dt0 - 32, tr, cfar, r32, hi);
#pragma unroll
    for (int d0 = 0; d0 < 4; ++d0) { s0 = MFMA32(k0[d0], t.q[d0], s0); s1 = MFMA32(k1[d0], t.q[d0], s1); }
    ca_finish(s0, v0, t); ca_finish(s1, v1, t);
}
constexpr int CA_SLOT = 8192, CA_WAVE_LDS = 2 * CA_SLOT, CA_RING_OFF = 2048;
__device__ __forceinline__ void ca_dma_tile(const bf16* Kh, const bf16* Vh, int k0, int r32, int hi, LAS unsigned char* slot) {
    const bf16* kp = Kh + (size_t)(k0 + r32) * 64 + 8 * hi;
    const bf16* vp = Vh + ((size_t)(k0 >> 6) * 64 + r32) * 64 + ((k0 >> 5) & 1) * 32 + 8 * hi;
#pragma unroll
    for (int d0 = 0; d0 < 4; ++d0) __builtin_amdgcn_global_load_lds((const unsigned*)(kp + 16 * d0), (LAS unsigned*)(slot + 1024 * d0), 16, 0, 0);
#pragma unroll
    for (int db = 0; db < 2; ++db)
#pragma unroll
        for (int sx = 0; sx < 2; ++sx) __builtin_amdgcn_global_load_lds((const unsigned*)(vp + db * 2048 + sx * 16), (LAS unsigned*)(slot + 4096 + 1024 * (db * 2 + sx)), 16, 0, 0);
}
__device__ __forceinline__ void ca_read_tile(bf16x8 (&kf)[4], bf16x8 (&vf)[4], const LAS unsigned char* slot, int lane) {
#pragma unroll
    for (int i = 0; i < 4; ++i) { kf[i] = *(const LAS bf16x8*)(slot + 1024 * i + 16 * lane); vf[i] = *(const LAS bf16x8*)(slot + 4096 + 1024 * i + 16 * lane); }
}
__device__ __forceinline__ void ca_unit(int b, int h, int t0, const bf16* Q, const bf16* K, const bf16* Vt, bf16* O, const LAS float* tr, LAS unsigned char* ring, int lane) {
    const int r32 = lane & 31, hi = lane >> 5;
    const size_t bh = (size_t)b * NH + h;
    const bf16* Kh = K + bh * SEQ * 64; const bf16* Vh = Vt + bh * SEQ * 64;
    const int c = t0 >> 6, kstart = (c >= 8) ? (c - 8) * 64 : 0, kend = t0 + 64;
    ca_dma_tile(Kh, Vh, kstart, r32, hi, ring);
    ca_dma_tile(Kh, Vh, kstart + 32, r32, hi, ring + CA_SLOT);
    QTile A, B;
    load_q(A, Q + (bh * SEQ + t0 + r32) * 64, hi); load_q(B, Q + (bh * SEQ + t0 + 32 + r32) * 64, hi);
    A.run = 0.f; B.run = 0.f;
    const float cfar = tr[0];
    bf16x8 kf[4], vf[4];
    for (int k0 = kstart; k0 < kend; k0 += 64) {
        asm volatile("s_waitcnt vmcnt(8)" ::: "memory");
        ca_read_tile(kf, vf, ring, lane);
        asm volatile("s_waitcnt lgkmcnt(0)" ::: "memory");
        if (k0 + 64 < kend) ca_dma_tile(Kh, Vh, k0 + 64, r32, hi, ring);
        ca_tile(kf, vf, A, t0 - k0, tr, cfar, r32, hi); ca_tile(kf, vf, B, t0 + 32 - k0, tr, cfar, r32, hi);
        if (k0 + 64 < kend) asm volatile("s_waitcnt vmcnt(8)" ::: "memory"); else asm volatile("s_waitcnt vmcnt(0)" ::: "memory");
        ca_read_tile(kf, vf, ring + CA_SLOT, lane);
        asm volatile("s_waitcnt lgkmcnt(0)" ::: "memory");
        if (k0 + 96 < kend) ca_dma_tile(Kh, Vh, k0 + 96, r32, hi, ring + CA_SLOT);
        ca_tile(kf, vf, A, t0 - k0 - 32, tr, cfar, r32, hi); ca_tile(kf, vf, B, t0 - k0, tr, cfar, r32, hi);
    }
    const float la = A.run + partner(A.run, hi), lb = B.run + partner(B.run, hi);
    store_o(O, (size_t)b * SEQ + t0 + r32, h, hi, A.o0, A.o1, 1.0f / la);
    store_o(O, (size_t)b * SEQ + t0 + 32 + r32, h, hi, B.o0, B.o1, 1.0f / lb);
}
constexpr int CC_STAGE = 16384, CC_RING_OFF = 2048;
__device__ __forceinline__ void cc_dma_stage(const bf16* Kh, const bf16* Vh, int j, int wave, int lane, LAS unsigned char* buf) {
    const int row = 8 * wave + (lane >> 3), c = (lane & 7) ^ ((row >> 1) & 7);
    __builtin_amdgcn_global_load_lds((const unsigned*)(Kh + (size_t)(64 * j + row) * 64 + c * 8), (LAS unsigned*)(buf + 1024 * wave), 16, 0, 0);
    __builtin_amdgcn_global_load_lds((const unsigned*)(Vh + (size_t)(64 * j + row) * 64 + c * 8), (LAS unsigned*)(buf + 8192 + 1024 * wave), 16, 0, 0);
}
__device__ __forceinline__ void cc_unit(int b, int h, int c0, const bf16* Q, const bf16* K, const bf16* Vt, bf16* O, const LAS float* tr, LAS unsigned char* ring, int wave, int lane) {
    const int r32 = lane & 31, hi = lane >> 5;
    const size_t bh = (size_t)b * NH + h;
    const bf16* Kh = K + bh * SEQ * 64; const bf16* Vh = Vt + bh * SEQ * 64;
    const int cw = c0 + (wave >> 1), t0 = 64 * cw + 32 * (wave & 1);
    const int jlo = c0 >= 8 ? c0 - 8 : 0, jhi = c0 + 3;
    QTile T; load_q(T, Q + (bh * SEQ + t0 + r32) * 64, hi); T.run = 0.f;
#pragma unroll
    for (int q = 0; q < 3; ++q) if (jlo + q <= jhi) cc_dma_stage(Kh, Vh, jlo + q, wave, lane, ring + q * CC_STAGE);
    const int key = (r32 >> 1) & 7;
    const int koff = r32 * 128, c_hi = hi;
    float cfar = 0.f;
    for (int j = jlo; j <= jhi; ++j) {
        LAS unsigned char* buf = ring + ((j - jlo) & 3) * CC_STAGE;
        if (jhi - j >= 2) asm volatile("s_waitcnt vmcnt(4) lgkmcnt(0)\n\ts_barrier" ::: "memory");
        else if (jhi - j == 1) asm volatile("s_waitcnt vmcnt(2) lgkmcnt(0)\n\ts_barrier" ::: "memory");
        else asm volatile("s_waitcnt vmcnt(0) lgkmcnt(0)\n\ts_barrier" ::: "memory");
        if (j == jlo) cfar = tr[0];
        if (j + 3 <= jhi) cc_dma_stage(Kh, Vh, j + 3, wave, lane, ring + ((j + 3 - jlo) & 3) * CC_STAGE);
        if (j >= cw - 8 && j <= cw) {
            bf16x8 kf0[4], vf0[4], kf1[4], vf1[4];
#pragma unroll
            for (int d0 = 0; d0 < 4; ++d0) { kf0[d0] = *(const LAS bf16x8*)(buf + koff + (((2 * d0 + c_hi) ^ key) * 16)); kf1[d0] = *(const LAS bf16x8*)(buf + 4096 + koff + (((2 * d0 + c_hi) ^ key) * 16)); }
#pragma unroll
            for (int db = 0; db < 2; ++db)
#pragma unroll
                for (int sx = 0; sx < 2; ++sx) { vf0[db * 2 + sx] = *(const LAS bf16x8*)(buf + 8192 + db * 4096 + koff + (((2 * sx + c_hi) ^ key) * 16));
                                                 vf1[db * 2 + sx] = *(const LAS bf16x8*)(buf + 8192 + db * 4096 + koff + (((4 + 2 * sx + c_hi) ^ key) * 16)); }
            ca_tile2(kf0, vf0, kf1, vf1, T, t0 - 64 * j, tr, cfar, r32, hi);
        }
    }
    const float l = T.run + partner(T.run, hi);
    store_o(O, (size_t)b * SEQ + t0 + r32, h, hi, T.o0, T.o1, 1.0f / l);
}
__device__ __forceinline__ float ca_head_bound(const float* gq, const float* gk, const float* rb, int lane) {
    float a = fabsf(gq[lane]), c = fabsf(gk[lane]), m = -3.0e38f;
    for (int i = lane; i < NREL; i += 64) m = fmaxf(m, rb[i]);
#pragma unroll
    for (int o = 1; o < 64; o <<= 1) { a = fmaxf(a, __shfl_xor(a, o)); c = fmaxf(c, __shfl_xor(c, o)); m = fmaxf(m, __shfl_xor(m, o)); }
    return LOG2E * (8.f * a * c + m);
}
}

#define XB_TMO      128
#define XB_XCNT(j)  (256  + 64 * (j))
#define XB_XSUB(j)  (1280 + 64 * (j))
#define XB_XGEN(j)  (2304 + 64 * (j))
#define XB_TOP      3328
#define XB_TOPGEN   3392
#define XCD_BAR_WORDS 3456
#define XB_SPIN_CAP (1u << 18)

__device__ __forceinline__ unsigned xb_ld(unsigned* p)              { return __hip_atomic_load(p, __ATOMIC_RELAXED, __HIP_MEMORY_SCOPE_AGENT); }
__device__ __forceinline__ unsigned xb_add(unsigned* p, unsigned v) { return __hip_atomic_fetch_add(p, v, __ATOMIC_RELAXED, __HIP_MEMORY_SCOPE_AGENT); }
__device__ __forceinline__ unsigned xb_xcc_id() { return (unsigned)__builtin_amdgcn_s_getreg((3 << 11) | 20) & 0xFu; }
#define XB_SPIN(cond, bar) do { unsigned _sp = 0; while (cond) { __builtin_amdgcn_s_sleep(1); \
    if ((++_sp & 255u) == 0u) { if (xb_ld(&(bar)[XB_TMO])) break; if (_sp > XB_SPIN_CAP) { atomicAdd(&(bar)[XB_TMO], 1u); break; } } } } while (0)

struct XcdBarrier {
    unsigned* bar; unsigned x;
    volatile LAS unsigned* st;
};

__device__ __forceinline__ XcdBarrier xcd_barrier_post(unsigned* bar, volatile LAS unsigned* st) {
    XcdBarrier b; b.bar = bar; b.x = xb_xcc_id(); b.st = st;
    if (threadIdx.x == 0) (void)xb_add(&bar[XB_XCNT(b.x)], 1u);
    return b;
}
__device__ __forceinline__ void xcd_barrier_complete(unsigned* bar, unsigned x, unsigned& nloc, unsigned& nx) {
    const unsigned G = gridDim.x * gridDim.y * gridDim.z;
    unsigned sum, cnt, mine, sp = 0u;
    for (;;) {
        sum = 0u; cnt = 0u; mine = 0u;
#pragma unroll
        for (unsigned j = 0; j < 16; ++j) { const unsigned c = xb_ld(&bar[XB_XCNT(j)]); sum += c; cnt += (c > 0u) ? 1u : 0u; mine = (j == x) ? c : mine; }
        if (sum == G) break;
        __builtin_amdgcn_s_sleep(1);
        if ((++sp & 255u) == 0u) { if (xb_ld(&bar[XB_TMO])) break; if (sp > XB_SPIN_CAP) { atomicAdd(&bar[XB_TMO], 1u); break; } }
    }
    nloc = mine > 0u ? mine : 1u; nx = cnt > 0u ? cnt : 1u;
}

__device__ __forceinline__ void xcd_barrier(const XcdBarrier& b) {
    asm volatile("s_waitcnt vmcnt(0)" ::: "memory");
    __syncthreads();
    if (threadIdx.x == 0) {
        unsigned* bar = b.bar;
        __builtin_amdgcn_s_waitcnt(0);
        unsigned nloc = b.st[0], nx = b.st[1];
        if (nloc == 0u) { xcd_barrier_complete(bar, b.x, nloc, nx); b.st[0] = nloc; b.st[1] = nx; }
        const unsigned old = xb_add(&bar[XB_XSUB(b.x)], 1u);
        const unsigned gen = old / nloc;
        if (old + 1u == (gen + 1u) * nloc) {
            __builtin_amdgcn_fence(__ATOMIC_RELEASE, "agent");
            asm volatile("s_waitcnt vmcnt(0)" ::: "memory");
            const unsigned og = xb_add(&bar[XB_TOP], 1u);
            const unsigned tg = og / nx;
            if (og + 1u == (tg + 1u) * nx) xb_add(&bar[XB_TOPGEN], 1u);
            else XB_SPIN(xb_ld(&bar[XB_TOPGEN]) == tg, bar);
            __builtin_amdgcn_fence(__ATOMIC_ACQUIRE, "agent");
            xb_add(&bar[XB_XGEN(b.x)], 1u);
            asm volatile("s_waitcnt vmcnt(0)" ::: "memory");
        } else {
            XB_SPIN(xb_ld(&bar[XB_XGEN(b.x)]) == gen, bar);
            __builtin_amdgcn_fence(__ATOMIC_ACQUIRE, "agent");
            asm volatile("s_waitcnt vmcnt(0)" ::: "memory");
        }
    }
    __syncthreads();
}

__device__ __forceinline__ float wave_sum(float v) {
#pragma unroll
    for (int o = 1; o < 16; o <<= 1) v += __shfl_xor(v, o);
    return pg8::sum_fq4(v);
}
__device__ __forceinline__ unsigned pk2(float lo, float hi) { return att::cvtpk(lo, hi); }

struct WItem { const float* src; const float* gain; bf16* dst; int ldn, K; };
__device__ __forceinline__ void witem_load(const WItem& w, f32x4 (&v)[8], float (&g)[8], int lane) {
    const int kq = lane >> 3, n4 = (lane & 7) * 4;
#pragma unroll
    for (int i = 0; i < 8; ++i) { v[i] = *(const f32x4*)(w.src + (size_t)(8 * i + kq) * w.ldn + n4); g[i] = w.gain ? w.gain[8 * i + kq] : 1.f; }
}
__device__ __forceinline__ void witem_finish(const WItem& w, const f32x4 (&v)[8], const float (&g)[8], LAS float* scr, int lane) {
    const int kq = lane >> 3, n4 = (lane & 7) * 4;
#pragma unroll
    for (int i = 0; i < 8; ++i) { LAS float* d = scr + (8 * i + kq) * 33 + n4; const f32x4 y = v[i] * g[i]; d[0] = y.x; d[1] = y.y; d[2] = y.z; d[3] = y.w; }
    asm volatile("s_waitcnt lgkmcnt(0)" ::: "memory");
    const int c = lane & 7;
#pragma unroll
    for (int j = 0; j < 4; ++j) { const int n = (lane >> 3) + 8 * j; const LAS float* q = scr + (8 * c) * 33 + n;
        v4u o; o.x = pk2(q[0 * 33], q[1 * 33]); o.y = pk2(q[2 * 33], q[3 * 33]); o.z = pk2(q[4 * 33], q[5 * 33]); o.w = pk2(q[6 * 33], q[7 * 33]);
        *(v4u*)(w.dst + (size_t)n * w.K + 8 * c) = o; }
    asm volatile("s_waitcnt lgkmcnt(0)" ::: "memory");
}
__device__ __forceinline__ void xrow_load(const float* xrow, f32x4 (&v)[4], int lane) {
    const f32x4* xr = (const f32x4*)xrow + 2 * lane;
#pragma unroll
    for (int j = 0; j < 4; ++j) v[j] = xr[128 * (j >> 1) + (j & 1)];
}
__device__ __forceinline__ void xrow_finish(const f32x4 (&v)[4], bf16* orow, float* ssp, int lane) {
    float s = 0.f;
#pragma unroll
    for (int j = 0; j < 4; ++j) s += (v[j].x * v[j].x + v[j].y * v[j].y) + (v[j].z * v[j].z + v[j].w * v[j].w);
    s = wave_sum(s);
    v4u* o16 = (v4u*)orow + lane;
#pragma unroll
    for (int j = 0; j < 2; ++j) { v4u w; w.x = pk2(v[2 * j].x, v[2 * j].y); w.y = pk2(v[2 * j].z, v[2 * j].w); w.z = pk2(v[2 * j + 1].x, v[2 * j + 1].y); w.w = pk2(v[2 * j + 1].z, v[2 * j + 1].w); o16[64 * j] = w; }
    if (lane < 16) ssp[lane] = lane == 0 ? s : 0.f;
}
struct Args { const float* in[10]; float* out; unsigned char* ws; int ph_lo, ph_hi; };
constexpr int PH_PER_LAYER = 5, NPH = 1 + DEPTH * PH_PER_LAYER;

__global__ void __launch_bounds__(NWAVES * 64, 2) mk_fwd(Args args) {
    extern __shared__ __attribute__((aligned(16))) unsigned char lds[];
    cg::grid_group grid = cg::this_grid();
    LAS unsigned char* ldsl = (LAS unsigned char*)lds;
    const int tid = threadIdx.x, lane = tid & 63, wave = __builtin_amdgcn_readfirstlane(tid >> 6);
    const int G = gridDim.x, bx = blockIdx.x;
    const int gw = bx * NWAVES + wave, NGW = G * NWAVES;
    unsigned char* ws = args.ws;
    const int lo = args.ph_lo, hi = args.ph_hi;
    const float* x_in = args.in[0];
    float* xres = args.out;
    float* SS = (float*)(ws + WS_SS); bf16* XB = (bf16*)(ws + WS_XB); bf16* QB = (bf16*)(ws + WS_Q); bf16* KB = (bf16*)(ws + WS_K); bf16* VT = (bf16*)(ws + WS_VT); bf16* OB = (bf16*)(ws + WS_O); bf16* HB = (bf16*)(ws + WS_H);
    volatile LAS unsigned* MISC = (volatile LAS unsigned*)(ldsl + MISC_OFF);
    if (tid < 2) MISC[tid] = 0u;
    __syncthreads();
    XcdBarrier bar = xcd_barrier_post((unsigned*)(ws + WS_BAR), MISC);
    if (lo < 0) grid.sync();
#define SEAM(ph) do { if ((ph) + 1 < hi) xcd_barrier(bar); } while (0)
#define IN(ph) (lo <= (ph) && (ph) < hi)

    if (IN(0)) {
        LAS float* scr = (LAS float*)(ldsl + wave * 16384);
        constexpr int I_QKV = 16 * 96, I_O = 16 * 32, I_UP = 16 * 128, I_DN = 64 * 32, I_LAYER = I_QKV + I_O + I_UP + I_DN, I_ALL = DEPTH * I_LAYER;
#define WITEM_DECODE(W_, it_) do { const int layer_ = (it_) / I_LAYER; int r_ = (it_) % I_LAYER; unsigned char* wl_ = ws + WS_W + (size_t)layer_ * W_LAYER; \
        if (r_ < I_QKV) { const int kb = r_ / 96, nb = r_ % 96, n0 = 32 * nb; int drow; bf16* base; \
            if (n0 < 2048) { const int blk = n0 >> 10, nn = n0 & 1023, head = nn >> 6, dh = (nn >> 5) & 1, pn = head >> 2, hl = head & 3; drow = blk * 1024 + 256 * pn + 128 * dh + 32 * hl; base = (bf16*)(wl_ + W_QK); } \
            else { drow = n0 - 2048; base = (bf16*)(wl_ + W_V); } \
            W_.src = args.in[2] + (size_t)layer_ * DM * 3 * DM + (size_t)(64 * kb) * (3 * DM) + n0; W_.gain = args.in[1] + layer_ * DM + 64 * kb; W_.dst = base + (size_t)drow * DM + 64 * kb; W_.ldn = 3 * DM; W_.K = DM; } \
        else if ((r_ -= I_QKV) < I_O) { const int kb = r_ / 32, nb = r_ % 32; \
            W_.src = args.in[3] + (size_t)layer_ * DM * DM + (size_t)(64 * kb) * DM + 32 * nb; W_.gain = nullptr; W_.dst = (bf16*)(wl_ + W_O) + (size_t)(32 * nb) * DM + 64 * kb; W_.ldn = DM; W_.K = DM; } \
        else if ((r_ -= I_O) < I_UP) { const int kb = r_ / 128, nb = r_ % 128; \
            W_.src = args.in[8] + (size_t)layer_ * DM * FF + (size_t)(64 * kb) * FF + 32 * nb; W_.gain = args.in[7] + layer_ * DM + 64 * kb; W_.dst = (bf16*)(wl_ + W_UP) + (size_t)(32 * nb) * DM + 64 * kb; W_.ldn = FF; W_.K = DM; } \
        else { r_ -= I_UP; const int kb = r_ / 32, nb = r_ % 32; \
            W_.src = args.in[9] + (size_t)layer_ * FF * DM + (size_t)(64 * kb) * DM + 32 * nb; W_.gain = nullptr; W_.dst = (bf16*)(wl_ + W_DN) + (size_t)(32 * nb) * FF + 64 * kb; W_.ldn = DM; W_.K = FF; } } while (0)
        {
            WItem wa, wb; f32x4 va[8], vb[8]; float ga[8], gb[8];
            int it = gw;
            if (it < I_ALL) { WITEM_DECODE(wa, it); witem_load(wa, va, ga, lane); }
            while (it < I_ALL) {
                const int itn = it + NGW;
                if (itn < I_ALL) { WITEM_DECODE(wb, itn); witem_load(wb, vb, gb, lane); }
                witem_finish(wa, va, ga, scr, lane);
                it = itn; wa = wb;
#pragma unroll
                for (int i = 0; i < 8; ++i) { va[i] = vb[i]; ga[i] = gb[i]; }
            }
        }
#undef WITEM_DECODE
        if (gw < 2 * NH) { const int mi = gw >> 4, hh = gw & 15; const float* rb = args.in[6] + ((size_t)mi * NH + hh) * NREL;
            const float m0 = att::ca_head_bound(args.in[4] + mi * HD, args.in[5] + mi * HD, rb, lane);
            float* trg = (float*)(ws + WS_TR) + (size_t)gw * att::NTR;
            for (int j = lane; j < att::NTR; j += 64) trg[j] = rb[512 - j] * LOG2E - m0; }
        for (int m = gw; m < MTOK; m += 4 * NGW) {
            f32x4 xv[4][4];
#pragma unroll
            for (int r = 0; r < 4; ++r) if (m + r * NGW < MTOK) xrow_load(x_in + (size_t)(m + r * NGW) * DM, xv[r], lane);
#pragma unroll
            for (int r = 0; r < 4; ++r) if (m + r * NGW < MTOK) xrow_finish(xv[r], XB + (size_t)(m + r * NGW) * DM, SS + (size_t)(m + r * NGW) * 16, lane);
        }
        SEAM(0);
    }

    for (int layer = 0; layer < DEPTH; ++layer) {
        const int p0 = 1 + layer * PH_PER_LAYER;
        if (hi <= p0 || lo >= p0 + PH_PER_LAYER) continue;
        unsigned char* wl = ws + WS_W + (size_t)layer * W_LAYER;
        const int mixer = layer & 1, midx = layer >> 1;

        if (IN(p0 + 0)) {
            {
            { pg8::Gemm g{XB, (const bf16*)(wl + W_QK), MTOK, 2 * DM, DM}; pg8::StaticOrder S; S.init(MTOK, 2 * DM, G, bx);
              pg8::EpiQK E{QB, KB, args.in[4] + midx * HD, args.in[5] + midx * HD, mixer, QSCALE, SS + (size_t)(2 * layer) * SS_INST};
              pg8::gemm_phase<pg8::EpiQK, pg8::StaticOrder, true, true>(ldsl, g, S, E); }
            { pg8::Gemm g{(const bf16*)(wl + W_V), XB, DM, MTOK, DM}; pg8::StaticOrder S; S.init(DM, MTOK, G, bx);
              pg8::EpiVt E{VT, SS + (size_t)(2 * layer) * SS_INST};
              pg8::gemm_phase<pg8::EpiVt, pg8::StaticOrder, true, true>(ldsl, g, S, E); }
            }
            SEAM(p0 + 0);
        }
        if (IN(p0 + 1)) {
            LAS float* tr = (LAS float*)ldsl;
            if (wave >= 4) __builtin_amdgcn_s_setprio(1);
            if (mixer == 0) {
                for (int u = bx; u < BATCH * NH * (SEQ / 512); u += G) {
                    int tid_o = threadIdx.x; asm volatile("" : "+v"(tid_o));
                    const int lane_o = tid_o & 63;
                    const int bh = u >> 4, qb = u & 15, b = bh >> 4, h = bh & 15, t0 = qb * 512 + wave * 64;
                    att::sb_unit(b, h, t0, QB, KB, VT, OB, lane_o);
                }
            } else {
                for (int u = bx; u < BATCH * NH * (SEQ / 256); u += G) {
                    int tid_o = threadIdx.x; asm volatile("" : "+v"(tid_o));
                    const int lane_o = tid_o & 63;
                    const int bh = u >> 5, qb = u & 31, b = bh >> 4, h = bh & 15;
                    const float* trg = (const float*)(ws + WS_TR) + (size_t)(midx * NH + h) * att::NTR;
                    __syncthreads();
                    if (tid_o < att::NTR) tr[tid_o] = trg[tid_o];
                    att::cc_unit(b, h, 4 * qb, QB, KB, VT, OB, tr, ldsl + att::CC_RING_OFF, wave, lane_o);
                }
            }
            __builtin_amdgcn_s_setprio(0);
            __syncthreads();
            SEAM(p0 + 1);
        }
        if (IN(p0 + 2)) {
            pg8::Gemm g{OB, (const bf16*)(wl + W_O), MTOK, DM, DM}; pg8::StaticOrder S; S.init(MTOK, DM, G, bx);
            pg8::EpiResid E{XB, DM, layer == 0 ? x_in : nullptr, nullptr, SS + (size_t)(2 * layer + 1) * SS_INST};
            pg8::gemm_phase<pg8::EpiResid, pg8::StaticOrder, true, true>(ldsl, g, S, E);
            SEAM(p0 + 2);
        }
        if (IN(p0 + 3)) {
            pg8::Gemm g{XB, (const bf16*)(wl + W_UP), MTOK, FF, DM}; pg8::StaticOrder S; S.init(MTOK, FF, G, bx);
            pg8::EpiBf16<1> E{HB, FF, SS + (size_t)(2 * layer + 1) * SS_INST};
            pg8::gemm_phase<pg8::EpiBf16<1>, pg8::StaticOrder, true, true>(ldsl, g, S, E);
            SEAM(p0 + 3);
        }
        if (IN(p0 + 4)) {
            pg8::Gemm g{HB, (const bf16*)(wl + W_DN), MTOK, DM, FF}; pg8::StaticOrder S; S.init(MTOK, DM, G, bx);
            pg8::EpiResid E{XB, DM, nullptr, layer + 1 < DEPTH ? nullptr : xres, layer + 1 < DEPTH ? SS + (size_t)(2 * layer + 2) * SS_INST : nullptr};
            pg8::gemm_phase<pg8::EpiResid, pg8::StaticOrder, true, true>(ldsl, g, S, E);
            SEAM(p0 + 4);
        }
    }
#undef SEAM
#undef IN
}

#ifndef MK_ONE_LAUNCH
#define MK_ONE_LAUNCH 0
#endif
extern "C" void kernel_launch(void* const* d_in, const int* in_sizes, int n_in, void* d_out, int out_size, void* d_ws, size_t ws_size, hipStream_t stream) {
    static int grid = 0;
    if (grid == 0) {
        if (n_in != 10 || in_sizes[0] != MTOK * DM || out_size != MTOK * DM || ws_size < WS_END) {
            fprintf(stderr, "kernel_launch: unexpected shapes / workspace (n_in %d, in0 %d, out %d, ws %zu < %zu)\n", n_in, n_in > 0 ? in_sizes[0] : -1, out_size, ws_size, (size_t)WS_END); grid = -1; return; }
        int dev = 0, cus = 0, per_cu = 0;
        (void)hipGetDevice(&dev); (void)hipDeviceGetAttribute(&cus, hipDeviceAttributeMultiprocessorCount, dev);
        if (hipFuncSetAttribute((const void*)mk_fwd, hipFuncAttributeMaxDynamicSharedMemorySize, LDS_BYTES) != hipSuccess) { fprintf(stderr, "kernel_launch: hipFuncSetAttribute failed\n"); grid = -1; return; }
        if (hipOccupancyMaxActiveBlocksPerMultiprocessor(&per_cu, (const void*)mk_fwd, NWAVES * 64, LDS_BYTES) != hipSuccess || per_cu < 1) { fprintf(stderr, "kernel_launch: occupancy query says %d blocks per CU\n", per_cu); per_cu = 1; }
        (void)hipGetLastError();
        grid = cus * per_cu;
    }
    if (grid < 0) return;
    if (hipMemsetAsync((char*)d_ws + WS_BAR, 0, BAR_ZERO_BYTES, stream) != hipSuccess) { fprintf(stderr, "kernel_launch: hipMemsetAsync failed\n"); return; }
    Args a{};
    for (int i = 0; i < 10; ++i) a.in[i] = (const float*)d_in[i];
    a.out = (float*)d_out; a.ws = (unsigned char*)d_ws;
#if MK_ONE_LAUNCH
    a.ph_lo = 0; a.ph_hi = NPH;
    void* kargs[] = {&a};
    hipError_t e = hipLaunchCooperativeKernel((const void*)mk_fwd, dim3(grid), dim3(NWAVES * 64), kargs, LDS_BYTES, stream);
    if (e != hipSuccess) fprintf(stderr, "kernel_launch: cooperative launch failed: %s (grid %d)\n", hipGetErrorString(e), grid);
#else
    for (int p = 0; p < NPH; ++p) {
        a.ph_lo = p; a.ph_hi = p + 1;
        hipLaunchKernelGGL(mk_fwd, dim3(grid), dim3(NWAVES * 64), LDS_BYTES, stream, a);
    }
#endif
}
```

```cpp
#include <hip/hip_runtime.h>
#include <hip/hip_cooperative_groups.h>
#include <cstdio>
#include <cstdint>
namespace cg = cooperative_groups;
#define MK_ONE_LAUNCH 1
namespace pg8 {
#define PG8_LAS __attribute__((address_space(3)))
typedef unsigned short bf16_t;
typedef short bf16x8 __attribute__((ext_vector_type(8)));
typedef float f32x4 __attribute__((ext_vector_type(4)));
typedef unsigned u32x4 __attribute__((ext_vector_type(4)));
constexpr int BM = 256, BK = 64, HALF = 128, HTB = HALF * BK * 2  , STAGE_BYTES = 8 * HTB, NXCD = 8, WGM = 4;

__host__ __device__ __forceinline__ int lds_byte(int r, int c) { const int st = (r >> 4) * 2 + (c >> 5), rr = r & 15, cc = c & 31, ob = rr * 64 + cc * 2; return st * 1024 + (ob ^ (((ob >> 9) & 1) << 5)); }
__host__ __device__ __forceinline__ void stage_rc(int b, int& R, int& C) { const int st = b / 1024, sb = b % 1024, swz = sb ^ (((sb >> 9) & 1) << 5); R = (st >> 1) * 16 + swz / 64; C = (st & 1) * 32 + (swz % 64) / 2; }
__host__ __device__ __forceinline__ int perm32(int rho) { const int n = rho >> 4, i = rho & 15; return 8 * (i >> 2) + 4 * n + (i & 3); }

struct Unit { int pm, pn; };
struct Gemm { const bf16_t* A; const bf16_t* Bt; int M, N, K; };

struct StaticOrder {
    int nM, nN, nwg, G, c;
    __host__ __device__ void init(int M, int N, int G_, int c_) { nM = M / BM; nN = N / BM; nwg = nM * nN; G = G_; c = c_; }
    __host__ __device__ bool next(int i, Unit& u) const {
        const long L = (long)i * G + c; if (L >= nwg) return false;
        int wgid = (int)L; { const int q = nwg / NXCD, r = nwg % NXCD, xcd = wgid % NXCD, off = wgid / NXCD; wgid = (xcd < r ? xcd * (q + 1) : r * (q + 1) + (xcd - r) * q) + off; }
        const int nig = WGM * nN, gid = wgid / nig, fm = gid * WGM, gsz = (nM - fm) < WGM ? (nM - fm) : WGM;
        u.pm = fm + ((wgid % nig) % gsz); u.pn = (wgid % nig) / gsz; return true;
    }
    __device__ __forceinline__ void a_ready(const Unit&) const {}
    __device__ __forceinline__ void done(const Unit&) const {}
};

__device__ __forceinline__ unsigned cvt_pk_bf16(float lo, float hi) { unsigned r; asm volatile("v_cvt_pk_bf16_f32 %0, %1, %2" : "=v"(r) : "v"(lo), "v"(hi)); return r; }
typedef float f32x2 __attribute__((ext_vector_type(2)));
typedef float f32x2 __attribute__((ext_vector_type(2)));
__device__ __forceinline__ float sum_fq4(float x) {
    auto a = __builtin_amdgcn_permlane16_swap(__float_as_uint(x), __float_as_uint(x), false, false);
    const float y = __uint_as_float(a[0]) + __uint_as_float(a[1]);
    auto b = __builtin_amdgcn_permlane32_swap(__float_as_uint(y), __float_as_uint(y), false, false);
    return __uint_as_float(b[0]) + __uint_as_float(b[1]);
}
__device__ __forceinline__ float row_rinv_q(const float* ssp, int row, int fq) {
    const f32x4 a = ((const f32x4*)(ssp + (size_t)row * 16))[fq];
    float s = (a[0] + a[1]) + (a[2] + a[3]);
    s = sum_fq4(s);
    return __builtin_amdgcn_rsqf(s * (1.0f / 1024.0f) + 1e-6f);
}
__device__ __forceinline__ float row_rinv(const float* ssp, int row) {
    const f32x4* p = (const f32x4*)(ssp + (size_t)row * 16);
    const f32x4 a = p[0], b = p[1], c = p[2], d = p[3];
    const f32x4 s = (a + b) + (c + d);
    return __builtin_amdgcn_rsqf(((s[0] + s[1]) + (s[2] + s[3])) * (1.0f / 1024.0f) + 1e-6f);
}
template <int ACT> struct EpiBf16 {
    static constexpr bool PERM = true, AFTER_DRAIN = false;
    bf16_t* O; int ldc; const float* ss;
    __device__ __forceinline__ void operator()(const f32x4 (&acc)[2][2][4][2], const Unit& u, int wr, int wc, int fr, int fq) const {
        const int row0 = u.pm * BM + wr * 64 + fr, col0 = u.pn * BM + wc * 32 + 8 * fq;
        float rinv[2][4];
#pragma unroll
        for (int ai = 0; ai < 2; ++ai)
#pragma unroll
            for (int m = 0; m < 4; ++m) rinv[ai][m] = ss ? row_rinv_q(ss, row0 + ai * HALF + m * 16, fq) : 1.f;
#pragma unroll
        for (int ai = 0; ai < 2; ++ai)
#pragma unroll
            for (int m = 0; m < 4; ++m) { bf16_t* rowp = O + (size_t)(row0 + ai * HALF + m * 16) * ldc + col0;
                const float rr = rinv[ai][m];
#pragma unroll
                for (int bj = 0; bj < 2; ++bj) { f32x4 v0 = acc[ai][bj][m][0] * rr, v1 = acc[ai][bj][m][1] * rr;
                    if (ACT == 1) { const f32x4 z = (f32x4){0.f, 0.f, 0.f, 0.f}; v0 = __builtin_elementwise_max(v0, z); v1 = __builtin_elementwise_max(v1, z); v0 = v0 * v0; v1 = v1 * v1; }
                    u32x4 w; w.x = cvt_pk_bf16(v0[0], v0[1]); w.y = cvt_pk_bf16(v0[2], v0[3]); w.z = cvt_pk_bf16(v1[0], v1[1]); w.w = cvt_pk_bf16(v1[2], v1[3]);
                    *(u32x4*)(rowp + bj * HALF) = w; } }
    }
};
struct EpiQK {
    static constexpr bool PERM = true, AFTER_DRAIN = false;
    bf16_t* Q; bf16_t* K; const float* gq; const float* gk; int norm; float qscale; const float* ss;
    __device__ __forceinline__ void operator()(const f32x4 (&acc)[2][2][4][2], const Unit& u, int wr, int wc, int fr, int fq) const {
        const int t = u.pn >> 2; bf16_t* base = t ? K : Q; const float* gp = t ? gk : gq;
        const int head = ((u.pn & 3) << 2) + wc, row0 = u.pm * BM + wr * 64 + fr;
        const float sc = t ? 1.f : qscale;
        f32x4 g[2][2];
#pragma unroll
        for (int bj = 0; bj < 2; ++bj)
#pragma unroll
            for (int n = 0; n < 2; ++n) { f32x4 gv = (f32x4){1.f, 1.f, 1.f, 1.f}; if (norm) gv = *(const f32x4*)(gp + 32 * bj + 8 * fq + 4 * n); g[bj][n] = gv * sc; }
        float rinv[2][4];
#pragma unroll
        for (int ai = 0; ai < 2; ++ai)
#pragma unroll
            for (int m = 0; m < 4; ++m) rinv[ai][m] = row_rinv_q(ss, row0 + ai * HALF + m * 16, fq);
#pragma unroll
        for (int ai = 0; ai < 2; ++ai)
#pragma unroll
            for (int m = 0; m < 4; ++m) {
                const int trow = row0 + ai * HALF + m * 16;
                float r = rinv[ai][m];
                if (norm) { float s2 = 0.f;
#pragma unroll
                    for (int bj = 0; bj < 2; ++bj)
#pragma unroll
                        for (int n = 0; n < 2; ++n) { const f32x4 x = acc[ai][bj][m][n] * r; s2 += (x[0] * x[0] + x[1] * x[1]) + (x[2] * x[2] + x[3] * x[3]); }
                    s2 = sum_fq4(s2);
                    r *= __builtin_amdgcn_rsqf(s2 * (1.0f / 64.0f) + 1e-6f); }
                bf16_t* rowp = base + ((size_t)((trow >> 13) * 16 + head) * 8192 + (trow & 8191)) * 64 + 8 * fq;
#pragma unroll
                for (int bj = 0; bj < 2; ++bj) { const f32x4 v0 = acc[ai][bj][m][0] * g[bj][0] * r, v1 = acc[ai][bj][m][1] * g[bj][1] * r;
                    u32x4 w; w.x = cvt_pk_bf16(v0[0], v0[1]); w.y = cvt_pk_bf16(v0[2], v0[3]); w.z = cvt_pk_bf16(v1[0], v1[1]); w.w = cvt_pk_bf16(v1[2], v1[3]);
                    *(u32x4*)(rowp + 32 * bj) = w; } }
    }
};
struct EpiResid {
    static constexpr bool PERM = true, AFTER_DRAIN = false;
    bf16_t* xb; int ldc; const float* xin; float* fin; float* ss;
    __device__ __forceinline__ void operator()(const f32x4 (&acc)[2][2][4][2], const Unit& u, int wr, int wc, int fr, int fq) const {
        const int col0 = u.pn * BM + wc * 32 + 8 * fq;
#pragma unroll
        for (int ai = 0; ai < 2; ++ai) {
            const int rowa = u.pm * BM + ai * HALF + wr * 64 + fr;
            f32x4 pre[4][2][2];
#pragma unroll
            for (int m = 0; m < 4; ++m)
#pragma unroll
                for (int bj = 0; bj < 2; ++bj) { const size_t off = (size_t)(rowa + m * 16) * ldc + col0 + bj * HALF;
                    if (xin) { pre[m][bj][0] = *(const f32x4*)(xin + off); pre[m][bj][1] = *(const f32x4*)(xin + off + 4); }
                    else { const u32x4 w = *(const u32x4*)(xb + off);
                        pre[m][bj][0] = (f32x4){__uint_as_float(w.x << 16), __uint_as_float(w.x & 0xffff0000u), __uint_as_float(w.y << 16), __uint_as_float(w.y & 0xffff0000u)};
                        pre[m][bj][1] = (f32x4){__uint_as_float(w.z << 16), __uint_as_float(w.z & 0xffff0000u), __uint_as_float(w.w << 16), __uint_as_float(w.w & 0xffff0000u)}; } }
#pragma unroll
            for (int m = 0; m < 4; ++m) { const int row = rowa + m * 16; const size_t off = (size_t)row * ldc + col0; float s2 = 0.f;
#pragma unroll
                for (int bj = 0; bj < 2; ++bj) { const f32x4 y0 = pre[m][bj][0] + acc[ai][bj][m][0], y1 = pre[m][bj][1] + acc[ai][bj][m][1];
                    if (fin) { *(f32x4*)(fin + off + bj * HALF) = y0; *(f32x4*)(fin + off + bj * HALF + 4) = y1; }
                    else { u32x4 w; w.x = cvt_pk_bf16(y0[0], y0[1]); w.y = cvt_pk_bf16(y0[2], y0[3]); w.z = cvt_pk_bf16(y1[0], y1[1]); w.w = cvt_pk_bf16(y1[2], y1[3]); *(u32x4*)(xb + off + bj * HALF) = w; }
                    if (ss) s2 += ((y0[0] * y0[0] + y0[1] * y0[1]) + (y0[2] * y0[2] + y0[3] * y0[3])) + ((y1[0] * y1[0] + y1[1] * y1[1]) + (y1[2] * y1[2] + y1[3] * y1[3])); }
                if (ss) { s2 = sum_fq4(s2); if (fq == 0) ss[(size_t)row * 16 + u.pn * 4 + wc] = s2; } }
        }
    }
};
struct EpiVt {
    static constexpr bool PERM = true, AFTER_DRAIN = false;
    bf16_t* O; const float* ss;
    __device__ __forceinline__ void operator()(const f32x4 (&acc)[2][2][4][2], const Unit& u, int wr, int wc, int fr, int fq) const {
        typedef unsigned u32x2v __attribute__((ext_vector_type(2)));
        const int row0 = u.pm * BM + wr * 64 + fr, col0 = u.pn * BM + wc * 32 + 8 * fq;
        f32x4 rs[2][2];
#pragma unroll
        for (int bj = 0; bj < 2; ++bj)
#pragma unroll
            for (int n = 0; n < 2; ++n) rs[bj][n] = (f32x4){0.f, 0.f, 0.f, 0.f};
        {
            const float mine = row_rinv(ss, col0 + (fr >> 3) * HALF + (fr & 7));
            const int lbase = fq * 16;
#pragma unroll
            for (int bj = 0; bj < 2; ++bj)
#pragma unroll
                for (int n = 0; n < 2; ++n)
#pragma unroll
                    for (int e = 0; e < 4; ++e) rs[bj][n][e] = __shfl(mine, lbase + bj * 8 + 4 * n + e);
        }
#pragma unroll
        for (int ai = 0; ai < 2; ++ai)
#pragma unroll
            for (int m = 0; m < 4; ++m) { const int n = row0 + ai * HALF + m * 16, h = n >> 6, d = n & 63;
#pragma unroll
                for (int bj = 0; bj < 2; ++bj) { const int col = col0 + bj * HALF, b = col >> 13, t = col & 8191;
                    bf16_t* p = O + ((((size_t)(b * 16 + h) * 128 + (t >> 6)) * 64 + d) * 64) + (t & 48) + 8 * ((t >> 3) & 1);
                    const f32x4 v0 = acc[ai][bj][m][0] * rs[bj][0], v1 = acc[ai][bj][m][1] * rs[bj][1];
                    typedef float f2_t __attribute__((ext_vector_type(2))); typedef __bf16 b2_t __attribute__((ext_vector_type(2)));
                    const unsigned x0 = __builtin_bit_cast(unsigned, __builtin_convertvector((f2_t){v0[0], v0[1]}, b2_t)), x1 = __builtin_bit_cast(unsigned, __builtin_convertvector((f2_t){v0[2], v0[3]}, b2_t));
                    const unsigned y0 = __builtin_bit_cast(unsigned, __builtin_convertvector((f2_t){v1[0], v1[1]}, b2_t)), y1 = __builtin_bit_cast(unsigned, __builtin_convertvector((f2_t){v1[2], v1[3]}, b2_t));
                    auto r0 = __builtin_amdgcn_permlane16_swap(x0, y0, false, false);
                    auto r1 = __builtin_amdgcn_permlane16_swap(x1, y1, false, false);
                    u32x4 w; w.x = r0[0]; w.y = r1[0]; w.z = r0[1]; w.w = r1[1];
                    *(u32x4*)p = w; } }
    }
};
template <class Epi, class Sched, bool ALIGN_EPI = false, bool SP2 = false>
__device__ __forceinline__ void gemm_phase(PG8_LAS unsigned char* lds, const Gemm g, const Sched& S, const Epi& E) {
    int tid_ = threadIdx.x; asm volatile("" : "+v"(tid_));
    const int tid = tid_, wid = __builtin_amdgcn_readfirstlane(tid >> 6), lane = tid & 63, wr = wid >> 2, wc = wid & 3, fr = lane & 15, fq = lane >> 4;
    const int K = g.K, nt = K / BK;
    unsigned voffA[2], voffB[2];
#pragma unroll
    for (int i = 0; i < 2; ++i) { int R, C; stage_rc(tid * 16 + i * 8192, R, C); const int Rb = Epi::PERM ? ((R & ~31) + perm32(R & 31)) : R;
        voffA[i] = (unsigned)(R * K + C) * 2u; voffB[i] = (unsigned)(Rb * K + C) * 2u; }
    const size_t kstep = (size_t)(BK * 2);
    const size_t hstep = (size_t)HALF * K * 2;
    const size_t tstep = 2 * hstep;
    const unsigned ldsw = (unsigned)wid * 1024u;
    const int aoff = lds_byte(wr * 64 + fr, fq * 8), boff = lds_byte(wc * 32 + fr, fq * 8);
#define PG8_SA(b, h) (((b) * 2 + (h)) * HTB)
#define PG8_SB(b, h) ((4 + (b) * 2 + (h)) * HTB)
#define PG8_STAGE(bufoff, gbase, voff) do { _Pragma("unroll") for (int _i = 0; _i < 2; ++_i) \
        __builtin_amdgcn_global_load_lds((const unsigned*)((const char*)(gbase) + (voff)[_i]), (PG8_LAS unsigned*)(lds + (bufoff) + ldsw + _i * 8192), 16, 0, 0); } while (0)
#define PG8_LDA(dst, b, h) do { _Pragma("unroll") for (int m = 0; m < 4; ++m) _Pragma("unroll") for (int k = 0; k < 2; ++k) dst[m][k] = *(const PG8_LAS bf16x8*)(lds + PG8_SA(b, h) + aoff + m * 2048 + k * 1024); } while (0)
#define PG8_LDB(dst, b, h) do { _Pragma("unroll") for (int n = 0; n < 2; ++n) _Pragma("unroll") for (int k = 0; k < 2; ++k) dst[n][k] = *(const PG8_LAS bf16x8*)(lds + PG8_SB(b, h) + boff + n * 2048 + k * 1024); } while (0)
#define PG8_MMA(ai, bj, At, Bt) do { __builtin_amdgcn_s_setprio(1); _Pragma("unroll") for (int m = 0; m < 4; ++m) _Pragma("unroll") for (int n = 0; n < 2; ++n) _Pragma("unroll") for (int k = 0; k < 2; ++k) \
        acc[ai][bj][m][n] = __builtin_amdgcn_mfma_f32_16x16x32_bf16(Bt[n][k], At[m][k], acc[ai][bj][m][n], 0, 0, 0); __builtin_amdgcn_s_setprio(0); } while (0)
#define PG8_WAIT_V(n) asm volatile("s_waitcnt vmcnt(" #n ")" ::: "memory")
#define PG8_WAIT_L(n) asm volatile("s_waitcnt lgkmcnt(" #n ")" ::: "memory")
#define PG8_BAR __builtin_amdgcn_s_barrier()
#define PG8_SCHED __builtin_amdgcn_sched_barrier(0)
    Unit cur, nxt; int ui = 0;
    if (!S.next(0, cur)) return;
    f32x4 acc[2][2][4][2];
#pragma unroll
    for (int a = 0; a < 2; ++a)
#pragma unroll
        for (int b = 0; b < 2; ++b)
#pragma unroll
            for (int m = 0; m < 4; ++m)
#pragma unroll
                for (int n = 0; n < 2; ++n) acc[a][b][m][n] = (f32x4){0.f, 0.f, 0.f, 0.f};
    bf16x8 At[4][2], B0[2][2], B1[2][2];
    const char* cA = (const char*)g.A + (size_t)cur.pm * tstep; const char* cB = (const char*)g.Bt + (size_t)cur.pn * tstep;
    S.a_ready(cur);
    if constexpr (SP2) {
        PG8_STAGE(PG8_SB(0, 0), cB, voffB); PG8_STAGE(PG8_SB(0, 1), cB + hstep, voffB); PG8_STAGE(PG8_SA(0, 0), cA, voffA); PG8_STAGE(PG8_SA(0, 1), cA + hstep, voffA);
        if (wr == 1) PG8_BAR;
        PG8_WAIT_V(2); PG8_BAR;
        PG8_STAGE(PG8_SB(1, 0), cB + kstep, voffB); PG8_STAGE(PG8_SA(1, 0), cA + kstep, voffA); PG8_STAGE(PG8_SB(1, 1), cB + hstep + kstep, voffB);
        PG8_WAIT_V(6); PG8_BAR;
    } else {
        PG8_STAGE(PG8_SB(0, 0), cB, voffB); PG8_STAGE(PG8_SA(0, 0), cA, voffA); PG8_STAGE(PG8_SB(0, 1), cB + hstep, voffB); PG8_STAGE(PG8_SA(0, 1), cA + hstep, voffA);
        if (wr == 1) PG8_BAR;
        PG8_WAIT_V(4); PG8_BAR;
        PG8_STAGE(PG8_SB(1, 0), cB + kstep, voffB); PG8_STAGE(PG8_SA(1, 0), cA + kstep, voffA); PG8_STAGE(PG8_SB(1, 1), cB + hstep + kstep, voffB);
        PG8_WAIT_V(6); PG8_BAR;
    }
    for (;;) {
        const bool has_next = S.next(ui + 1, nxt);
        const char* nA = has_next ? (const char*)g.A + (size_t)nxt.pm * tstep : cA; const char* nB = has_next ? (const char*)g.Bt + (size_t)nxt.pn * tstep : cB;
        for (int t = 0; t < nt; t += 2) {
            const bool last = (t == nt - 2);
            const char* a1 = cA + (size_t)(t + 1) * kstep;
            const char* a2 = last ? nA : cA + (size_t)(t + 2) * kstep; const char* b2 = last ? nB : cB + (size_t)(t + 2) * kstep;
            const char* a3 = a2 + kstep; const char* b3 = b2 + kstep;
            if (last && has_next) S.a_ready(nxt);
            if constexpr (SP2) {
            PG8_LDB(B0, 0, 0); PG8_LDB(B1, 0, 1); PG8_SCHED; PG8_LDA(At, 0, 0); PG8_STAGE(PG8_SA(1, 1), a1 + hstep, voffA);
            PG8_WAIT_V(8); PG8_WAIT_L(0); PG8_BAR; PG8_MMA(0, 0, At, B0); PG8_MMA(0, 1, At, B1); PG8_BAR; PG8_SCHED;
            PG8_LDA(At, 0, 1); PG8_STAGE(PG8_SB(0, 0), b2, voffB); PG8_STAGE(PG8_SB(0, 1), b2 + hstep, voffB); PG8_STAGE(PG8_SA(0, 0), a2, voffA);
            PG8_WAIT_V(8); PG8_WAIT_L(0); PG8_BAR; PG8_MMA(1, 0, At, B0); PG8_MMA(1, 1, At, B1); PG8_BAR; PG8_SCHED;
            PG8_LDB(B0, 1, 0); PG8_LDB(B1, 1, 1); PG8_SCHED; PG8_LDA(At, 1, 0); PG8_STAGE(PG8_SA(0, 1), a2 + hstep, voffA);
            PG8_WAIT_V(8); PG8_WAIT_L(0); PG8_BAR; PG8_MMA(0, 0, At, B0); PG8_MMA(0, 1, At, B1); PG8_BAR; PG8_SCHED;
            PG8_LDA(At, 1, 1); PG8_STAGE(PG8_SB(1, 0), b3, voffB); PG8_STAGE(PG8_SB(1, 1), b3 + hstep, voffB); PG8_STAGE(PG8_SA(1, 0), a3, voffA);
            PG8_WAIT_V(8); PG8_WAIT_L(0); PG8_BAR; PG8_MMA(1, 0, At, B0); PG8_MMA(1, 1, At, B1); PG8_BAR; PG8_SCHED;
            } else {
            PG8_LDB(B0, 0, 0); PG8_SCHED; PG8_LDA(At, 0, 0); PG8_STAGE(PG8_SA(1, 1), a1 + hstep, voffA);
            PG8_WAIT_L(8); PG8_BAR; PG8_WAIT_L(0); PG8_MMA(0, 0, At, B0); PG8_BAR; PG8_SCHED;
            PG8_LDB(B1, 0, 1); PG8_STAGE(PG8_SB(0, 0), b2, voffB);
            PG8_BAR; PG8_WAIT_L(0); PG8_MMA(0, 1, At, B1); PG8_BAR;
            PG8_LDA(At, 0, 1); PG8_STAGE(PG8_SA(0, 0), a2, voffA);
            PG8_BAR; PG8_WAIT_L(0); PG8_MMA(1, 0, At, B0); PG8_BAR; PG8_SCHED;
            PG8_STAGE(PG8_SB(0, 1), b2 + hstep, voffB);
            PG8_WAIT_V(6); PG8_BAR; PG8_MMA(1, 1, At, B1); PG8_BAR;
            PG8_LDB(B0, 1, 0); PG8_SCHED; PG8_LDA(At, 1, 0); PG8_STAGE(PG8_SA(0, 1), a2 + hstep, voffA);
            PG8_WAIT_L(8); PG8_BAR; PG8_WAIT_L(0); PG8_MMA(0, 0, At, B0); PG8_BAR; PG8_SCHED;
            PG8_LDB(B1, 1, 1); PG8_STAGE(PG8_SB(1, 0), b3, voffB);
            PG8_BAR; PG8_WAIT_L(0); PG8_MMA(0, 1, At, B1); PG8_BAR;
            PG8_LDA(At, 1, 1); PG8_STAGE(PG8_SA(1, 0), a3, voffA);
            PG8_BAR; PG8_WAIT_L(0); PG8_MMA(1, 0, At, B0); PG8_BAR; PG8_SCHED;
            PG8_STAGE(PG8_SB(1, 1), b3 + hstep, voffB);
            PG8_WAIT_V(6); PG8_BAR; PG8_MMA(1, 1, At, B1); PG8_BAR;
            }
        }
        if constexpr (ALIGN_EPI) { if (wr == 0) PG8_BAR; }
        if constexpr (!Epi::AFTER_DRAIN) { E(acc, cur, wr, wc, fr, fq); S.done(cur); }
        if (!has_next) break;
#pragma unroll
        for (int a = 0; a < 2; ++a)
#pragma unroll
            for (int b = 0; b < 2; ++b)
#pragma unroll
                for (int m = 0; m < 4; ++m)
#pragma unroll
                    for (int n = 0; n < 2; ++n) acc[a][b][m][n] = (f32x4){0.f, 0.f, 0.f, 0.f};
        cur = nxt; cA = nA; cB = nB; ++ui;
        if constexpr (ALIGN_EPI) { if (wr == 1) PG8_BAR; }
    }
    PG8_WAIT_V(0);
    if constexpr (!ALIGN_EPI) { if (wr == 0) PG8_BAR; }
    PG8_BAR;
    if constexpr (Epi::AFTER_DRAIN) { E.fused(acc, cur, wr, wc, fr, fq, lds, wid, lane); S.done(cur); }
#undef PG8_SA
#undef PG8_SB
#undef PG8_STAGE
#undef PG8_LDA
#undef PG8_LDB
#undef PG8_MMA
#undef PG8_WAIT_V
#undef PG8_WAIT_L
#undef PG8_BAR
#undef PG8_SCHED
}
}

constexpr int BATCH = 4, SEQ = 8192, DM = 1024, NH = 16, HD = 64, FF = 4096, DEPTH = 4;
constexpr int MTOK = BATCH * SEQ;
constexpr int NREL = 513;
constexpr float RMS_EPS = 1e-6f;
constexpr float QSCALE = 0.125f * 1.4426950408889634f;
constexpr float LOG2E = 1.4426950408889634f;

#define LAS __attribute__((address_space(3)))
typedef unsigned short bf16;
typedef unsigned v4u __attribute__((ext_vector_type(4)));
typedef float f32x4 __attribute__((ext_vector_type(4)));

constexpr size_t MiB = 1u << 20;

constexpr size_t WS_TR = 65536;
constexpr size_t WS_BAR = 0, BAR_ZERO_BYTES = 16384;
constexpr size_t WS_W = 1 * MiB;
constexpr size_t W_LAYER = 24 * MiB, W_QK = 0, W_V = 4 * MiB, W_O = 6 * MiB, W_UP = 8 * MiB, W_DN = 16 * MiB;
constexpr size_t WS_XB = WS_W + DEPTH * W_LAYER;
constexpr size_t WS_Q = WS_XB + 64 * MiB;
constexpr size_t WS_K = WS_Q + 64 * MiB;
constexpr size_t WS_VT = WS_K + 64 * MiB;
constexpr size_t WS_O = WS_VT + 64 * MiB;
constexpr size_t WS_H = WS_Q;
constexpr size_t WS_SS = WS_H + 256 * MiB;
constexpr size_t SS_INST = (size_t)MTOK * 16;
constexpr size_t WS_END = WS_SS + 16 * MiB;

constexpr int NWAVES = 8;
constexpr int RING_BYTES = 131072;
constexpr int LDS_BYTES = 147456;
constexpr int MISC_OFF = LDS_BYTES - 64;

namespace att {
typedef short bf16x8 __attribute__((ext_vector_type(8)));
typedef short s16x4 __attribute__((ext_vector_type(4)));
typedef float f32x16 __attribute__((ext_vector_type(16)));
typedef float f32x2_t __attribute__((ext_vector_type(2)));
typedef __bf16 bf16x2_t __attribute__((ext_vector_type(2)));
typedef unsigned u32x2 __attribute__((ext_vector_type(2)));
typedef unsigned u32x4 __attribute__((ext_vector_type(4)));
#define MFMA32(a, b, c) __builtin_amdgcn_mfma_f32_32x32x16_bf16((a), (b), (c), 0, 0, 0)
__device__ __forceinline__ unsigned cvtpk(float lo, float hi) { f32x2_t v = {lo, hi}; bf16x2_t b = __builtin_convertvector(v, bf16x2_t); return __builtin_bit_cast(unsigned, b); }
__device__ __forceinline__ int crow(int r, int hi) { return (r & 3) + 8 * (r >> 2) + 4 * hi; }
__device__ __forceinline__ float partner(float v, int hi) {
    auto rr = __builtin_amdgcn_permlane32_swap(__float_as_uint(v), __float_as_uint(v), false, false);
    return __uint_as_float(hi ? rr[0] : rr[1]);
}
__device__ __forceinline__ bf16x8 pack8(const float* a) {
    u32x4 p; p.x = cvtpk(a[0], a[1]); p.y = cvtpk(a[2], a[3]); p.z = cvtpk(a[4], a[5]); p.w = cvtpk(a[6], a[7]);
    return __builtin_bit_cast(bf16x8, p);
}
struct QTile { bf16x8 q[4]; f32x16 o0, o1; float run; };
__device__ __forceinline__ void load_k(bf16x8 (&k)[4], const bf16* Kh, int k0, int r32, int hi) {
    const bf16* kp = Kh + (size_t)(k0 + r32) * 64 + 8 * hi;
#pragma unroll
    for (int d0 = 0; d0 < 4; ++d0) k[d0] = *(const bf16x8*)(kp + 16 * d0);
}
__device__ __forceinline__ void load_v(bf16x8 (&v)[4], const bf16* Vh, int k0, int r32, int hi) {
    const bf16* vp = Vh + ((size_t)(k0 >> 6) * 64 + r32) * 64 + ((k0 >> 5) & 1) * 32 + 8 * hi;
#pragma unroll
    for (int db = 0; db < 2; ++db)
#pragma unroll
        for (int s = 0; s < 2; ++s) v[db * 2 + s] = *(const bf16x8*)(vp + db * 2048 + s * 16);
}
__device__ __forceinline__ void load_q(QTile& t, const bf16* qrow, int hi) {
#pragma unroll
    for (int d0 = 0; d0 < 4; ++d0) t.q[d0] = *(const bf16x8*)(qrow + 16 * d0 + 8 * hi);
    t.o0 = f32x16{}; t.o1 = f32x16{};
}
__device__ __forceinline__ void store_o(bf16* O, size_t row, int h, int hi, const f32x16& o0, const f32x16& o1, float sc) {
    bf16* op = O + row * DM + h * 64 + 8 * hi;
#pragma unroll
    for (int half = 0; half < 2; ++half) {
        const f32x16& o = half ? o1 : o0;
#pragma unroll
        for (int g = 0; g < 4; g += 2) {
            const unsigned a0 = cvtpk(o[4 * g] * sc, o[4 * g + 1] * sc), a1 = cvtpk(o[4 * g + 2] * sc, o[4 * g + 3] * sc);
            const unsigned b0 = cvtpk(o[4 * g + 4] * sc, o[4 * g + 5] * sc), b1 = cvtpk(o[4 * g + 6] * sc, o[4 * g + 7] * sc);
            auto r0 = __builtin_amdgcn_permlane32_swap(a0, b0, false, false);
            auto r1 = __builtin_amdgcn_permlane32_swap(a1, b1, false, false);
            u32x4 w; w.x = r0[0]; w.y = r1[0]; w.z = r0[1]; w.w = r1[1];
            *(u32x4*)(op + 32 * half + 8 * g) = w;
        }
    }
}

constexpr float SB_DONE = 9.094947e-13f;
__device__ __forceinline__ void sb_tile(const bf16x8 (&fk)[4], const bf16x8 (&fv)[4], QTile& t, bool diag, int r32, int hi) {
    f32x16 st = {};
#pragma unroll
    for (int d0 = 0; d0 < 4; ++d0) st = MFMA32(fk[d0], t.q[d0], st);
    float om[16];
#pragma unroll
    for (int r = 0; r < 16; ++r) {
        const float z = __builtin_amdgcn_fmed3f(st[r], -100.f, 100.f);
        const float e = __builtin_amdgcn_exp2f(-z);
        float o_ = e * __builtin_amdgcn_rcpf(1.f + e);
        if (diag) o_ = (crow(r, hi) < r32) ? o_ : 1.f;
        om[r] = o_;
    }
    float gp[4], gq[4], T[4];
#pragma unroll
    for (int g = 0; g < 4; ++g) { gp[g] = (om[4 * g] * om[4 * g + 1]) * (om[4 * g + 2] * om[4 * g + 3]); gq[g] = partner(gp[g], hi); T[g] = gp[g] * gq[g]; }
    float suf[4];
    suf[3] = t.run; suf[2] = suf[3] * T[3]; suf[1] = suf[2] * T[2]; suf[0] = suf[1] * T[1];
    t.run = suf[0] * T[0];
    float a[16];
#pragma unroll
    for (int g = 0; g < 4; ++g) {
        const float w3 = hi ? suf[g] : suf[g] * gq[g];
        const float w2 = w3 * om[4 * g + 3], w1 = w2 * om[4 * g + 2], w0 = w1 * om[4 * g + 1], wm = w0 * om[4 * g];
        a[4 * g + 3] = w3 - w2; a[4 * g + 2] = w2 - w1; a[4 * g + 1] = w1 - w0; a[4 * g] = w0 - wm;
    }
    const bf16x8 pa0 = pack8(a), pa1 = pack8(a + 8);
    t.o0 = MFMA32(fv[0], pa0, t.o0); t.o0 = MFMA32(fv[1], pa1, t.o0);
    t.o1 = MFMA32(fv[2], pa0, t.o1); t.o1 = MFMA32(fv[3], pa1, t.o1);
}
__device__ __forceinline__ void sb_unit(int b, int h, int t0, const bf16* Q, const bf16* K, const bf16* Vt, bf16* O, int lane) {
    const int r32 = lane & 31, hi = lane >> 5;
    const size_t bh = (size_t)b * NH + h;
    const bf16* Kh = K + bh * SEQ * 64; const bf16* Vh = Vt + bh * SEQ * 64;
    QTile A, B;
    load_q(A, Q + (bh * SEQ + t0 + r32) * 64, hi); load_q(B, Q + (bh * SEQ + t0 + 32 + r32) * 64, hi);
    A.run = 1.f; B.run = 1.f;
    bf16x8 ka[4], kb[4], vv[4];
    load_k(ka, Kh, t0 + 32, r32, hi); load_v(vv, Vh, t0 + 32, r32, hi);
    load_k(kb, Kh, t0, r32, hi);
    sb_tile(ka, vv, B, true, r32, hi);
    load_v(vv, Vh, t0, r32, hi);
    if (t0 >= 32) load_k(ka, Kh, t0 - 32, r32, hi);
    sb_tile(kb, vv, B, false, r32, hi); sb_tile(kb, vv, A, true, r32, hi);
    int k0 = t0 - 32;
    while (k0 >= 0) {
        bool dA = __all(A.run < SB_DONE), dB = __all(B.run < SB_DONE);
        if (dA && dB) break;
        load_v(vv, Vh, k0, r32, hi);
        if (k0 >= 32) load_k(kb, Kh, k0 - 32, r32, hi);
        if (!dB) sb_tile(ka, vv, B, false, r32, hi);
        if (!dA) sb_tile(ka, vv, A, false, r32, hi);
        k0 -= 32;
        if (k0 < 0) break;
        dA = __all(A.run < SB_DONE); dB = __all(B.run < SB_DONE);
        if (dA && dB) break;
        load_v(vv, Vh, k0, r32, hi);
        if (k0 >= 32) load_k(ka, Kh, k0 - 32, r32, hi);
        if (!dB) sb_tile(kb, vv, B, false, r32, hi);
        if (!dA) sb_tile(kb, vv, A, false, r32, hi);
        k0 -= 32;
    }
    store_o(O, (size_t)b * SEQ + t0 + r32, h, hi, A.o0, A.o1, 1.f);
    store_o(O, (size_t)b * SEQ + t0 + 32 + r32, h, hi, B.o0, B.o1, 1.f);
}

constexpr int NTR = 320;
__device__ __forceinline__ void ca_init(f32x16& st, int dt  , const LAS float* tr, float cfar, int r32, int hi) {
    if (dt >= 288) {
#pragma unroll
        for (int r = 0; r < 16; ++r) st[r] = cfar;
    } else {
        const int jb = 256 - dt - r32 + 4 * hi;
        if (dt <= 224) {
#pragma unroll
            for (int r = 0; r < 16; ++r) st[r] = tr[jb + (r & 3) + 8 * (r >> 2)];
        } else {
#pragma unroll
            for (int r = 0; r < 16; ++r) { int j = jb + (r & 3) + 8 * (r >> 2); j = j < 0 ? 0 : j; st[r] = tr[j]; }
        }
    }
}
__device__ __forceinline__ void ca_finish(const f32x16& st, const bf16x8 (&fv)[4], QTile& t) {
    float p[16]; float ps = 0.f;
#pragma unroll
    for (int r = 0; r < 16; ++r) { p[r] = __builtin_amdgcn_exp2f(st[r]); ps += p[r]; }
    t.run += ps;
    const bf16x8 pa0 = pack8(p), pa1 = pack8(p + 8);
    t.o0 = MFMA32(fv[0], pa0, t.o0); t.o0 = MFMA32(fv[1], pa1, t.o0);
    t.o1 = MFMA32(fv[2], pa0, t.o1); t.o1 = MFMA32(fv[3], pa1, t.o1);
}
__device__ __forceinline__ void ca_tile(const bf16x8 (&fk)[4], const bf16x8 (&fv)[4], QTile& t, int dt  , const LAS float* tr, float cfar, int r32, int hi) {
    f32x16 st; ca_init(st, dt, tr, cfar, r32, hi);
#pragma unroll
    for (int d0 = 0; d0 < 4; ++d0) st = MFMA32(fk[d0], t.q[d0], st);
    ca_finish(st, fv, t);
}
__device__ __forceinline__ void ca_tile2(const bf16x8 (&k0)[4], const bf16x8 (&v0)[4], const bf16x8 (&k1)[4], const bf16x8 (&v1)[4], QTile& t, int dt0, const LAS float* tr, float cfar, int r32, int hi) {
    f32x16 s0, s1; ca_init(s0, dt0, tr, cfar, r32, hi); ca_init(s1, dt0 - 32, tr, cfar, r32, hi);
#pragma unroll
    for (int d0 = 0; d0 < 4; ++d0) { s0 = MFMA32(k0[d0], t.q[d0], s0); s1 = MFMA32(k1[d0], t.q[d0], s1); }
    ca_finish(s0, v0, t); ca_finish(s1, v1, t);
}
constexpr int CA_SLOT = 8192, CA_WAVE_LDS = 2 * CA_SLOT, CA_RING_OFF = 2048;
__device__ __forceinline__ void ca_dma_tile(const bf16* Kh, const bf16* Vh, int k0, int r32, int hi, LAS unsigned char* slot) {
    const bf16* kp = Kh + (size_t)(k0 + r32) * 64 + 8 * hi;
    const bf16* vp = Vh + ((size_t)(k0 >> 6) * 64 + r32) * 64 + ((k0 >> 5) & 1) * 32 + 8 * hi;
#pragma unroll
    for (int d0 = 0; d0 < 4; ++d0) __builtin_amdgcn_global_load_lds((const unsigned*)(kp + 16 * d0), (LAS unsigned*)(slot + 1024 * d0), 16, 0, 0);
#pragma unroll
    for (int db = 0; db < 2; ++db)
#pragma unroll
        for (int sx = 0; sx < 2; ++sx) __builtin_amdgcn_global_load_lds((const unsigned*)(vp + db * 2048 + sx * 16), (LAS unsigned*)(slot + 4096 + 1024 * (db * 2 + sx)), 16, 0, 0);
}
__device__ __forceinline__ void ca_read_tile(bf16x8 (&kf)[4], bf16x8 (&vf)[4], const LAS unsigned char* slot, int lane) {
#pragma unroll
    for (int i = 0; i < 4; ++i) { kf[i] = *(const LAS bf16x8*)(slot + 1024 * i + 16 * lane); vf[i] = *(const LAS bf16x8*)(slot + 4096 + 1024 * i + 16 * lane); }
}
__device__ __forceinline__ void ca_unit(int b, int h, int t0, const bf16* Q, const bf16* K, const bf16* Vt, bf16* O, const LAS float* tr, LAS unsigned char* ring, int lane) {
    const int r32 = lane & 31, hi = lane >> 5;
    const size_t bh = (size_t)b * NH + h;
    const bf16* Kh = K + bh * SEQ * 64; const bf16* Vh = Vt + bh * SEQ * 64;
    const int c = t0 >> 6, kstart = (c >= 8) ? (c - 8) * 64 : 0, kend = t0 + 64;
    ca_dma_tile(Kh, Vh, kstart, r32, hi, ring);
    ca_dma_tile(Kh, Vh, kstart + 32, r32, hi, ring + CA_SLOT);
    QTile A, B;
    load_q(A, Q + (bh * SEQ + t0 + r32) * 64, hi); load_q(B, Q + (bh * SEQ + t0 + 32 + r32) * 64, hi);
    A.run = 0.f; B.run = 0.f;
    const float cfar = tr[0];
    bf16x8 kf[4], vf[4];
    for (int k0 = kstart; k0 < kend; k0 += 64) {
        asm volatile("s_waitcnt vmcnt(8)" ::: "memory");
        ca_read_tile(kf, vf, ring, lane);
        asm volatile("s_waitcnt lgkmcnt(0)" ::: "memory");
        if (k0 + 64 < kend) ca_dma_tile(Kh, Vh, k0 + 64, r32, hi, ring);
        ca_tile(kf, vf, A, t0 - k0, tr, cfar, r32, hi); ca_tile(kf, vf, B, t0 + 32 - k0, tr, cfar, r32, hi);
        if (k0 + 64 < kend) asm volatile("s_waitcnt vmcnt(8)" ::: "memory"); else asm volatile("s_waitcnt vmcnt(0)" ::: "memory");
        ca_read_tile(kf, vf, ring + CA_SLOT, lane);
        asm volatile("s_waitcnt lgkmcnt(0)" ::: "memory");
        if (k0 + 96 < kend) ca_dma_tile(Kh, Vh, k0 + 96, r32, hi, ring + CA_SLOT);
        ca_tile(kf, vf, A, t0 - k0 - 32, tr, cfar, r32, hi); ca_tile(kf, vf, B, t0 - k0, tr, cfar, r32, hi);
    }
    const float la = A.run + partner(A.run, hi), lb = B.run + partner(B.run, hi);
    store_o(O, (size_t)b * SEQ + t0 + r32, h, hi, A.o0, A.o1, 1.0f / la);
    store_o(O, (size_t)b * SEQ + t0 + 32 + r32, h, hi, B.o0, B.o1, 1.0f / lb);
}
constexpr int CC_STAGE = 16384, CC_RING_OFF = 2048;
__device__ __forceinline__ void cc_dma_stage(const bf16* Kh, const bf16* Vh, int j, int wave, int lane, LAS unsigned char* buf) {
    const int row = 8 * wave + (lane >> 3), c = (lane & 7) ^ ((row >> 1) & 7);
    __builtin_amdgcn_global_load_lds((const unsigned*)(Kh + (size_t)(64 * j + row) * 64 + c * 8), (LAS unsigned*)(buf + 1024 * wave), 16, 0, 0);
    __builtin_amdgcn_global_load_lds((const unsigned*)(Vh + (size_t)(64 * j + row) * 64 + c * 8), (LAS unsigned*)(buf + 8192 + 1024 * wave), 16, 0, 0);
}
__device__ __forceinline__ void cc_unit(int b, int h, int c0, const bf16* Q, const bf16* K, const bf16* Vt, bf16* O, const LAS float* tr, LAS unsigned char* ring, int wave, int lane) {
    const int r32 = lane & 31, hi = lane >> 5;
    const size_t bh = (size_t)b * NH + h;
    const bf16* Kh = K + bh * SEQ * 64; const bf16* Vh = Vt + bh * SEQ * 64;
    const int cw = c0 + (wave >> 1), t0 = 64 * cw + 32 * (wave & 1);
    const int jlo = c0 >= 8 ? c0 - 8 : 0, jhi = c0 + 3;
    QTile T; load_q(T, Q + (bh * SEQ + t0 + r32) * 64, hi); T.run = 0.f;
#pragma unroll
    for (int q = 0; q < 3; ++q) if (jlo + q <= jhi) cc_dma_stage(Kh, Vh, jlo + q, wave, lane, ring + q * CC_STAGE);
    const int key = (r32 >> 1) & 7;
    const int koff = r32 * 128, c_hi = hi;
    float cfar = 0.f;
    for (int j = jlo; j <= jhi; ++j) {
        LAS unsigned char* buf = ring + ((j - jlo) & 3) * CC_STAGE;
        if (jhi - j >= 2) asm volatile("s_waitcnt vmcnt(4) lgkmcnt(0)\n\ts_barrier" ::: "memory");
        else if (jhi - j == 1) asm volatile("s_waitcnt vmcnt(2) lgkmcnt(0)\n\ts_barrier" ::: "memory");
        else asm volatile("s_waitcnt vmcnt(0) lgkmcnt(0)\n\ts_barrier" ::: "memory");
        if (j == jlo) cfar = tr[0];
        if (j + 3 <= jhi) cc_dma_stage(Kh, Vh, j + 3, wave, lane, ring + ((j + 3 - jlo) & 3) * CC_STAGE);
        if (j >= cw - 8 && j <= cw) {
            bf16x8 kf0[4], vf0[4], kf1[4], vf1[4];
#pragma unroll
            for (int d0 = 0; d0 < 4; ++d0) { kf0[d0] = *(const LAS bf16x8*)(buf + koff + (((2 * d0 + c_hi) ^ key) * 16)); kf1[d0] = *(const LAS bf16x8*)(buf + 4096 + koff + (((2 * d0 + c_hi) ^ key) * 16)); }
#pragma unroll
            for (int db = 0; db < 2; ++db)
#pragma unroll
                for (int sx = 0; sx < 2; ++sx) { vf0[db * 2 + sx] = *(const LAS bf16x8*)(buf + 8192 + db * 4096 + koff + (((2 * sx + c_hi) ^ key) * 16));
                                                 vf1[db * 2 + sx] = *(const LAS bf16x8*)(buf + 8192 + db * 4096 + koff + (((4 + 2 * sx + c_hi) ^ key) * 16)); }
            ca_tile2(kf0, vf0, kf1, vf1, T, t0 - 64 * j, tr, cfar, r32, hi);
        }
    }
    const float l = T.run + partner(T.run, hi);
    store_o(O, (size_t)b * SEQ + t0 + r32, h, hi, T.o0, T.o1, 1.0f / l);
}
__device__ __forceinline__ float ca_head_bound(const float* gq, const float* gk, const float* rb, int lane) {
    float a = fabsf(gq[lane]), c = fabsf(gk[lane]), m = -3.0e38f;
    for (int i = lane; i < NREL; i += 64) m = fmaxf(m, rb[i]);
#pragma unroll
    for (int o = 1; o < 64; o <<= 1) { a = fmaxf(a, __shfl_xor(a, o)); c = fmaxf(c, __shfl_xor(c, o)); m = fmaxf(m, __shfl_xor(m, o)); }
    return LOG2E * (8.f * a * c + m);
}
}

#define XB_TMO      128
#define XB_XCNT(j)  (256  + 64 * (j))
#define XB_XSUB(j)  (1280 + 64 * (j))
#define XB_XGEN(j)  (2304 + 64 * (j))
#define XB_TOP      3328
#define XB_TOPGEN   3392
#define XCD_BAR_WORDS 3456
#define XB_SPIN_CAP (1u << 18)

__device__ __forceinline__ unsigned xb_ld(unsigned* p)              { return __hip_atomic_load(p, __ATOMIC_RELAXED, __HIP_MEMORY_SCOPE_AGENT); }
__device__ __forceinline__ unsigned xb_add(unsigned* p, unsigned v) { return __hip_atomic_fetch_add(p, v, __ATOMIC_RELAXED, __HIP_MEMORY_SCOPE_AGENT); }
__device__ __forceinline__ unsigned xb_xcc_id() { return (unsigned)__builtin_amdgcn_s_getreg((3 << 11) | 20) & 0xFu; }
#define XB_SPIN(cond, bar) do { unsigned _sp = 0; while (cond) { __builtin_amdgcn_s_sleep(1); \
    if ((++_sp & 255u) == 0u) { if (xb_ld(&(bar)[XB_TMO])) break; if (_sp > XB_SPIN_CAP) { atomicAdd(&(bar)[XB_TMO], 1u); break; } } } } while (0)

struct XcdBarrier {
    unsigned* bar; unsigned x;
    volatile LAS unsigned* st;
};

__device__ __forceinline__ XcdBarrier xcd_barrier_post(unsigned* bar, volatile LAS unsigned* st) {
    XcdBarrier b; b.bar = bar; b.x = xb_xcc_id(); b.st = st;
    if (threadIdx.x == 0) (void)xb_add(&bar[XB_XCNT(b.x)], 1u);
    return b;
}
__device__ __forceinline__ void xcd_barrier_complete(unsigned* bar, unsigned x, unsigned& nloc, unsigned& nx) {
    const unsigned G = gridDim.x * gridDim.y * gridDim.z;
    unsigned sum, cnt, mine, sp = 0u;
    for (;;) {
        sum = 0u; cnt = 0u; mine = 0u;
#pragma unroll
        for (unsigned j = 0; j < 16; ++j) { const unsigned c = xb_ld(&bar[XB_XCNT(j)]); sum += c; cnt += (c > 0u) ? 1u : 0u; mine = (j == x) ? c : mine; }
        if (sum == G) break;
        __builtin_amdgcn_s_sleep(1);
        if ((++sp & 255u) == 0u) { if (xb_ld(&bar[XB_TMO])) break; if (sp > XB_SPIN_CAP) { atomicAdd(&bar[XB_TMO], 1u); break; } }
    }
    nloc = mine > 0u ? mine : 1u; nx = cnt > 0u ? cnt : 1u;
}

__device__ __forceinline__ void xcd_barrier(const XcdBarrier& b) {
    asm volatile("s_waitcnt vmcnt(0)" ::: "memory");
    __syncthreads();
    if (threadIdx.x == 0) {
        unsigned* bar = b.bar;
        __builtin_amdgcn_s_waitcnt(0);
        unsigned nloc = b.st[0], nx = b.st[1];
        if (nloc == 0u) { xcd_barrier_complete(bar, b.x, nloc, nx); b.st[0] = nloc; b.st[1] = nx; }
        const unsigned old = xb_add(&bar[XB_XSUB(b.x)], 1u);
        const unsigned gen = old / nloc;
        if (old + 1u == (gen + 1u) * nloc) {
            __builtin_amdgcn_fence(__ATOMIC_RELEASE, "agent");
            asm volatile("s_waitcnt vmcnt(0)" ::: "memory");
            const unsigned og = xb_add(&bar[XB_TOP], 1u);
            const unsigned tg = og / nx;
            if (og + 1u == (tg + 1u) * nx) xb_add(&bar[XB_TOPGEN], 1u);
            else XB_SPIN(xb_ld(&bar[XB_TOPGEN]) == tg, bar);
            __builtin_amdgcn_fence(__ATOMIC_ACQUIRE, "agent");
            xb_add(&bar[XB_XGEN(b.x)], 1u);
            asm volatile("s_waitcnt vmcnt(0)" ::: "memory");
        } else {
            XB_SPIN(xb_ld(&bar[XB_XGEN(b.x)]) == gen, bar);
            __builtin_amdgcn_fence(__ATOMIC_ACQUIRE, "agent");
            asm volatile("s_waitcnt vmcnt(0)" ::: "memory");
        }
    }
    __syncthreads();
}

__device__ __forceinline__ float wave_sum(float v) {
#pragma unroll
    for (int o = 1; o < 16; o <<= 1) v += __shfl_xor(v, o);
    return pg8::sum_fq4(v);
}
__device__ __forceinline__ unsigned pk2(float lo, float hi) { return att::cvtpk(lo, hi); }

struct WItem { const float* src; const float* gain; bf16* dst; int ldn, K; };
__device__ __forceinline__ void witem_load(const WItem& w, f32x4 (&v)[8], float (&g)[8], int lane) {
    const int kq = lane >> 3, n4 = (lane & 7) * 4;
#pragma unroll
    for (int i = 0; i < 8; ++i) { v[i] = *(const f32x4*)(w.src + (size_t)(8 * i + kq) * w.ldn + n4); g[i] = w.gain ? w.gain[8 * i + kq] : 1.f; }
}
__device__ __forceinline__ void witem_finish(const WItem& w, const f32x4 (&v)[8], const float (&g)[8], LAS float* scr, int lane) {
    const int kq = lane >> 3, n4 = (lane & 7) * 4;
#pragma unroll
    for (int i = 0; i < 8; ++i) { LAS float* d = scr + (8 * i + kq) * 33 + n4; const f32x4 y = v[i] * g[i]; d[0] = y.x; d[1] = y.y; d[2] = y.z; d[3] = y.w; }
    asm volatile("s_waitcnt lgkmcnt(0)" ::: "memory");
    const int c = lane & 7;
#pragma unroll
    for (int j = 0; j < 4; ++j) { const int n = (lane >> 3) + 8 * j; const LAS float* q = scr + (8 * c) * 33 + n;
        v4u o; o.x = pk2(q[0 * 33], q[1 * 33]); o.y = pk2(q[2 * 33], q[3 * 33]); o.z = pk2(q[4 * 33], q[5 * 33]); o.w = pk2(q[6 * 33], q[7 * 33]);
        *(v4u*)(w.dst + (size_t)n * w.K + 8 * c) = o; }
    asm volatile("s_waitcnt lgkmcnt(0)" ::: "memory");
}
__device__ __forceinline__ void xrow_load(const float* xrow, f32x4 (&v)[4], int lane) {
    const f32x4* xr = (const f32x4*)xrow + 2 * lane;
#pragma unroll
    for (int j = 0; j < 4; ++j) v[j] = xr[128 * (j >> 1) + (j & 1)];
}
__device__ __forceinline__ void xrow_finish(const f32x4 (&v)[4], bf16* orow, float* ssp, int lane) {
    float s = 0.f;
#pragma unroll
    for (int j = 0; j < 4; ++j) s += (v[j].x * v[j].x + v[j].y * v[j].y) + (v[j].z * v[j].z + v[j].w * v[j].w);
    s = wave_sum(s);
    v4u* o16 = (v4u*)orow + lane;
#pragma unroll
    for (int j = 0; j < 2; ++j) { v4u w; w.x = pk2(v[2 * j].x, v[2 * j].y); w.y = pk2(v[2 * j].z, v[2 * j].w); w.z = pk2(v[2 * j + 1].x, v[2 * j + 1].y); w.w = pk2(v[2 * j + 1].z, v[2 * j + 1].w); o16[64 * j] = w; }
    if (lane < 16) ssp[lane] = lane == 0 ? s : 0.f;
}
struct Args { const float* in[10]; float* out; unsigned char* ws; int ph_lo, ph_hi; };
constexpr int PH_PER_LAYER = 5, NPH = 1 + DEPTH * PH_PER_LAYER;

__global__ void __launch_bounds__(NWAVES * 64, 2) mk_fwd(Args args) {
    extern __shared__ __attribute__((aligned(16))) unsigned char lds[];
    cg::grid_group grid = cg::this_grid();
    LAS unsigned char* ldsl = (LAS unsigned char*)lds;
    const int tid = threadIdx.x, lane = tid & 63, wave = __builtin_amdgcn_readfirstlane(tid >> 6);
    const int G = gridDim.x, bx = blockIdx.x;
    const int gw = bx * NWAVES + wave, NGW = G * NWAVES;
    unsigned char* ws = args.ws;
    const int lo = args.ph_lo, hi = args.ph_hi;
    const float* x_in = args.in[0];
    float* xres = args.out;
    float* SS = (float*)(ws + WS_SS); bf16* XB = (bf16*)(ws + WS_XB); bf16* QB = (bf16*)(ws + WS_Q); bf16* KB = (bf16*)(ws + WS_K); bf16* VT = (bf16*)(ws + WS_VT); bf16* OB = (bf16*)(ws + WS_O); bf16* HB = (bf16*)(ws + WS_H);
    volatile LAS unsigned* MISC = (volatile LAS unsigned*)(ldsl + MISC_OFF);
    if (tid < 2) MISC[tid] = 0u;
    __syncthreads();
    XcdBarrier bar = xcd_barrier_post((unsigned*)(ws + WS_BAR), MISC);
    if (lo < 0) grid.sync();
#define SEAM(ph) do { if ((ph) + 1 < hi) xcd_barrier(bar); } while (0)
#define IN(ph) (lo <= (ph) && (ph) < hi)

    if (IN(0)) {
        LAS float* scr = (LAS float*)(ldsl + wave * 16384);
        constexpr int I_QKV = 16 * 96, I_O = 16 * 32, I_UP = 16 * 128, I_DN = 64 * 32, I_LAYER = I_QKV + I_O + I_UP + I_DN, I_ALL = DEPTH * I_LAYER;
#define WITEM_DECODE(W_, it_) do { const int layer_ = (it_) / I_LAYER; int r_ = (it_) % I_LAYER; unsigned char* wl_ = ws + WS_W + (size_t)layer_ * W_LAYER; \
        if (r_ < I_QKV) { const int kb = r_ / 96, nb = r_ % 96, n0 = 32 * nb; int drow; bf16* base; \
            if (n0 < 2048) { const int blk = n0 >> 10, nn = n0 & 1023, head = nn >> 6, dh = (nn >> 5) & 1, pn = head >> 2, hl = head & 3; drow = blk * 1024 + 256 * pn + 128 * dh + 32 * hl; base = (bf16*)(wl_ + W_QK); } \
            else { drow = n0 - 2048; base = (bf16*)(wl_ + W_V); } \
            W_.src = args.in[2] + (size_t)layer_ * DM * 3 * DM + (size_t)(64 * kb) * (3 * DM) + n0; W_.gain = args.in[1] + layer_ * DM + 64 * kb; W_.dst = base + (size_t)drow * DM + 64 * kb; W_.ldn = 3 * DM; W_.K = DM; } \
        else if ((r_ -= I_QKV) < I_O) { const int kb = r_ / 32, nb = r_ % 32; \
            W_.src = args.in[3] + (size_t)layer_ * DM * DM + (size_t)(64 * kb) * DM + 32 * nb; W_.gain = nullptr; W_.dst = (bf16*)(wl_ + W_O) + (size_t)(32 * nb) * DM + 64 * kb; W_.ldn = DM; W_.K = DM; } \
        else if ((r_ -= I_O) < I_UP) { const int kb = r_ / 128, nb = r_ % 128; \
            W_.src = args.in[8] + (size_t)layer_ * DM * FF + (size_t)(64 * kb) * FF + 32 * nb; W_.gain = args.in[7] + layer_ * DM + 64 * kb; W_.dst = (bf16*)(wl_ + W_UP) + (size_t)(32 * nb) * DM + 64 * kb; W_.ldn = FF; W_.K = DM; } \
        else { r_ -= I_UP; const int kb = r_ / 32, nb = r_ % 32; \
            W_.src = args.in[9] + (size_t)layer_ * FF * DM + (size_t)(64 * kb) * DM + 32 * nb; W_.gain = nullptr; W_.dst = (bf16*)(wl_ + W_DN) + (size_t)(32 * nb) * FF + 64 * kb; W_.ldn = DM; W_.K = FF; } } while (0)
        {
            WItem wa, wb; f32x4 va[8], vb[8]; float ga[8], gb[8];
            int it = gw;
            if (it < I_ALL) { WITEM_DECODE(wa, it); witem_load(wa, va, ga, lane); }
            while (it < I_ALL) {
                const int itn = it + NGW;
                if (itn < I_ALL) { WITEM_DECODE(wb, itn); witem_load(wb, vb, gb, lane); }
                witem_finish(wa, va, ga, scr, lane);
                it = itn; wa = wb;
#pragma unroll
                for (int i = 0; i < 8; ++i) { va[i] = vb[i]; ga[i] = gb[i]; }
            }
        }
#undef WITEM_DECODE
        if (gw < 2 * NH) { const int mi = gw >> 4, hh = gw & 15; const float* rb = args.in[6] + ((size_t)mi * NH + hh) * NREL;
            const float m0 = att::ca_head_bound(args.in[4] + mi * HD, args.in[5] + mi * HD, rb, lane);
            float* trg = (float*)(ws + WS_TR) + (size_t)gw * att::NTR;
            for (int j = lane; j < att::NTR; j += 64) trg[j] = rb[512 - j] * LOG2E - m0; }
        for (int m = gw; m < MTOK; m += 4 * NGW) {
            f32x4 xv[4][4];
#pragma unroll
            for (int r = 0; r < 4; ++r) if (m + r * NGW < MTOK) xrow_load(x_in + (size_t)(m + r * NGW) * DM, xv[r], lane);
#pragma unroll
            for (int r = 0; r < 4; ++r) if (m + r * NGW < MTOK) xrow_finish(xv[r], XB + (size_t)(m + r * NGW) * DM, SS + (size_t)(m + r * NGW) * 16, lane);
        }
        SEAM(0);
    }

    for (int layer = 0; layer < DEPTH; ++layer) {
        const int p0 = 1 + layer * PH_PER_LAYER;
        if (hi <= p0 || lo >= p0 + PH_PER_LAYER) continue;
        unsigned char* wl = ws + WS_W + (size_t)layer * W_LAYER;
        const int mixer = layer & 1, midx = layer >> 1;

        if (IN(p0 + 0)) {
            {
            { pg8::Gemm g{XB, (const bf16*)(wl + W_QK), MTOK, 2 * DM, DM}; pg8::StaticOrder S; S.init(MTOK, 2 * DM, G, bx);
              pg8::EpiQK E{QB, KB, args.in[4] + midx * HD, args.in[5] + midx * HD, mixer, QSCALE, SS + (size_t)(2 * layer) * SS_INST};
              pg8::gemm_phase<pg8::EpiQK, pg8::StaticOrder, true, true>(ldsl, g, S, E); }
            { pg8::Gemm g{(const bf16*)(wl + W_V), XB, DM, MTOK, DM}; pg8::StaticOrder S; S.init(DM, MTOK, G, bx);
              pg8::EpiVt E{VT, SS + (size_t)(2 * layer) * SS_INST};
              pg8::gemm_phase<pg8::EpiVt, pg8::StaticOrder, true, true>(ldsl, g, S, E); }
            }
            SEAM(p0 + 0);
        }
        if (IN(p0 + 1)) {
            LAS float* tr = (LAS float*)ldsl;
            if (wave >= 4) __builtin_amdgcn_s_setprio(1);
            if (mixer == 0) {
                for (int u = bx; u < BATCH * NH * (SEQ / 512); u += G) {
                    int tid_o = threadIdx.x; asm volatile("" : "+v"(tid_o));
                    const int lane_o = tid_o & 63;
                    const int bh = u >> 4, qb = u & 15, b = bh >> 4, h = bh & 15, t0 = qb * 512 + wave * 64;
                    att::sb_unit(b, h, t0, QB, KB, VT, OB, lane_o);
                }
            } else {
                for (int u = bx; u < BATCH * NH * (SEQ / 256); u += G) {
                    int tid_o = threadIdx.x; asm volatile("" : "+v"(tid_o));
                    const int lane_o = tid_o & 63;
                    const int bh = u >> 5, qb = u & 31, b = bh >> 4, h = bh & 15;
                    const float* trg = (const float*)(ws + WS_TR) + (size_t)(midx * NH + h) * att::NTR;
                    __syncthreads();
                    if (tid_o < att::NTR) tr[tid_o] = trg[tid_o];
                    att::cc_unit(b, h, 4 * qb, QB, KB, VT, OB, tr, ldsl + att::CC_RING_OFF, wave, lane_o);
                }
            }
            __builtin_amdgcn_s_setprio(0);
            __syncthreads();
            SEAM(p0 + 1);
        }
        if (IN(p0 + 2)) {
            pg8::Gemm g{OB, (const bf16*)(wl + W_O), MTOK, DM, DM}; pg8::StaticOrder S; S.init(MTOK, DM, G, bx);
            pg8::EpiResid E{XB, DM, nullptr, nullptr, SS + (size_t)(2 * layer + 1) * SS_INST};
            pg8::gemm_phase<pg8::EpiResid, pg8::StaticOrder, true, true>(ldsl, g, S, E);
            SEAM(p0 + 2);
        }
        if (IN(p0 + 3)) {
            pg8::Gemm g{XB, (const bf16*)(wl + W_UP), MTOK, FF, DM}; pg8::StaticOrder S; S.init(MTOK, FF, G, bx);
            pg8::EpiBf16<1> E{HB, FF, SS + (size_t)(2 * layer + 1) * SS_INST};
            pg8::gemm_phase<pg8::EpiBf16<1>, pg8::StaticOrder, true, true>(ldsl, g, S, E);
            SEAM(p0 + 3);
        }
        if (IN(p0 + 4)) {
            pg8::Gemm g{HB, (const bf16*)(wl + W_DN), MTOK, DM, FF}; pg8::StaticOrder S; S.init(MTOK, DM, G, bx);
            pg8::EpiResid E{XB, DM, nullptr, layer + 1 < DEPTH ? nullptr : xres, layer + 1 < DEPTH ? SS + (size_t)(2 * layer + 2) * SS_INST : nullptr};
            pg8::gemm_phase<pg8::EpiResid, pg8::StaticOrder, true, true>(ldsl, g, S, E);
            SEAM(p0 + 4);
        }
    }
#undef SEAM
#undef IN
}

#ifndef MK_ONE_LAUNCH
#define MK_ONE_LAUNCH 0
#endif
extern "C" void kernel_launch(void* const* d_in, const int* in_sizes, int n_in, void* d_out, int out_size, void* d_ws, size_t ws_size, hipStream_t stream) {
    static int grid = 0;
    if (grid == 0) {
        if (n_in != 10 || in_sizes[0] != MTOK * DM || out_size != MTOK * DM || ws_size < WS_END) {
            fprintf(stderr, "kernel_launch: unexpected shapes / workspace (n_in %d, in0 %d, out %d, ws %zu < %zu)\n", n_in, n_in > 0 ? in_sizes[0] : -1, out_size, ws_size, (size_t)WS_END); grid = -1; return; }
        int dev = 0, cus = 0, per_cu = 0;
        (void)hipGetDevice(&dev); (void)hipDeviceGetAttribute(&cus, hipDeviceAttributeMultiprocessorCount, dev);
        if (hipFuncSetAttribute((const void*)mk_fwd, hipFuncAttributeMaxDynamicSharedMemorySize, LDS_BYTES) != hipSuccess) { fprintf(stderr, "kernel_launch: hipFuncSetAttribute failed\n"); grid = -1; return; }
        if (hipOccupancyMaxActiveBlocksPerMultiprocessor(&per_cu, (const void*)mk_fwd, NWAVES * 64, LDS_BYTES) != hipSuccess || per_cu < 1) { fprintf(stderr, "kernel_launch: occupancy query says %d blocks per CU\n", per_cu); per_cu = 1; }
        (void)hipGetLastError();
        grid = cus * per_cu;
    }
    if (grid < 0) return;
    if (hipMemsetAsync((char*)d_ws + WS_BAR, 0, BAR_ZERO_BYTES, stream) != hipSuccess) { fprintf(stderr, "kernel_launch: hipMemsetAsync failed\n"); return; }
    Args a{};
    for (int i = 0; i < 10; ++i) a.in[i] = (const float*)d_in[i];
    a.out = (float*)d_out; a.ws = (unsigned char*)d_ws;
#if MK_ONE_LAUNCH
    a.ph_lo = 0; a.ph_hi = NPH;
    void* kargs[] = {&a};
    hipError_t e = hipLaunchCooperativeKernel((const void*)mk_fwd, dim3(grid), dim3(NWAVES * 64), kargs, LDS_BYTES, stream);
    if (e != hipSuccess) fprintf(stderr, "kernel_launch: cooperative launch failed: %s (grid %d)\n", hipGetErrorString(e), grid);
#else
    for (int p = 0; p < NPH; ++p) {
        a.ph_lo = p; a.ph_hi = p + 1;
        hipLaunchKernelGGL(mk_fwd, dim3(grid), dim3(NWAVES * 64), LDS_BYTES, stream, a);
    }
#endif
}
```
